# Optimizing an MI355X kernel written in HIP

```python
import jax, jax.numpy as jnp
from jax import lax
import numpy as np

D_MODEL = 1024
BATCH = 8
SEQ = 4096
DEPTH = 2

CHUNK = 128
A_GROUPS = 4
A_GROUP_DIM = 128
A_WIDTH = A_GROUPS * A_GROUP_DIM
DIL_WINDOWS = (128, 512, 2048)
DIL_RATES = (1, 4, 16)
N_DIL = 3
B_HEADS = 8
B_HEAD_DIM = 64
B_WIDTH = B_HEADS * B_HEAD_DIM
ROPE_DIM = B_HEAD_DIM // 4
ROPE_THETA = 500000.0
C_WIDTH = 512
C_KERNEL = 31
D_WIDTH = 512
D_KERNEL = 3
D_FF = -(-8 * D_MODEL // (3 * 256)) * 256
EPS = 1e-6
NEG_INF = -1e30

AB_IN = 2 * A_WIDTH + 3 * N_DIL * B_HEADS * B_HEAD_DIM
AB_OUT = A_WIDTH + B_WIDTH
CD_IN = 2 * C_WIDTH + 3 * D_WIDTH
CD_OUT = C_WIDTH + D_WIDTH
N_AB = (DEPTH + 1) // 2
N_CD = DEPTH // 2

kernel_name = 'hybrid_gmlp_dilattn_conformer_shortconv'


def rms_norm(x, g):
    xf = x.astype(jnp.float32)
    y = xf * lax.rsqrt(jnp.mean(xf * xf, axis=-1, keepdims=True) + EPS)
    return (y * g.astype(jnp.float32)).astype(x.dtype)


def layer_norm(x, g, b):
    xf = x.astype(jnp.float32)
    xc = xf - jnp.mean(xf, axis=-1, keepdims=True)
    y = xc * lax.rsqrt(jnp.mean(xc * xc, axis=-1, keepdims=True) + EPS)
    return (y * g.astype(jnp.float32) + b.astype(jnp.float32)).astype(x.dtype)


def apply_rope(x, pos):
    half = ROPE_DIM // 2
    inv_freq = ROPE_THETA ** (-jnp.arange(half, dtype=jnp.float32) * 2.0 / ROPE_DIM)
    ang = pos[:, None] * inv_freq[None, :]
    cos = jnp.cos(ang)[None, :, None, :]
    sin = jnp.sin(ang)[None, :, None, :]
    xf = x.astype(jnp.float32)
    x1 = xf[..., :half]
    x2 = xf[..., half:ROPE_DIM]
    out = jnp.concatenate([x1 * cos - x2 * sin, x1 * sin + x2 * cos, xf[..., ROPE_DIM:]], axis=-1)
    return out.astype(x.dtype)


def causal_depthwise_conv(x, w):
    k, c = w.shape
    return lax.conv_general_dilated(
        x, w.astype(x.dtype)[:, None, :], window_strides=(1,), padding=[(k - 1, 0)],
        dimension_numbers=('NWC', 'WIO', 'NWC'), feature_group_count=c)


def chunked_spatial_gating(u, v, w_s, b_s):
    bn, s, _ = u.shape
    nc = s // CHUNK
    vg = v.reshape(bn, nc, CHUNK, A_GROUPS, A_GROUP_DIM)
    causal = jnp.tril(jnp.ones((CHUNK, CHUNK), dtype=bool))
    w = jnp.where(causal[None], w_s, 0.0).astype(v.dtype)
    mixed = jnp.einsum('gts,bnsgc->bntgc', w, vg) + b_s.T.astype(v.dtype)[None, None, :, :, None]
    return u * mixed.reshape(bn, s, A_WIDTH)


def dilated_group_attention(q, k, v, rate, n_back):
    bn, s, h, dh = q.shape
    span = rate * n_back
    s_pad = -(-s // span) * span
    length = s_pad // rate
    nb = length // n_back

    def to_blocks(t):
        t = jnp.pad(t, ((0, 0), (0, s_pad - s), (0, 0), (0, 0)))
        t = t.reshape(bn, length, rate, h, dh).transpose(0, 2, 1, 3, 4)
        return t.reshape(bn, rate, nb, n_back, h, dh)

    def with_prev(t):
        prev = jnp.pad(t[:, :, :-1], ((0, 0), (0, 0), (1, 0), (0, 0), (0, 0), (0, 0)))
        return jnp.concatenate([prev, t], axis=3)

    qb = to_blocks(q)
    kk = with_prev(to_blocks(k))
    vv = with_prev(to_blocks(v))
    scores = jnp.einsum('brnqhd,brnkhd->brnhqk', qb.astype(jnp.float32),
                        kk.astype(jnp.float32)) * (dh ** -0.5)
    qi = jnp.arange(n_back)[:, None]
    kj = jnp.arange(2 * n_back)[None, :]
    dist = qi + n_back - kj
    band = (dist >= 0) & (dist <= n_back)
    exists = (jnp.arange(nb)[:, None, None] > 0) | (kj[None] >= n_back)
    mask = band[None] & exists
    scores = jnp.where(mask[None, None, :, None], scores, NEG_INF)
    lse = jax.nn.logsumexp(scores, axis=-1)
    probs = jnp.exp(scores - lse[..., None])
    out = jnp.einsum('brnhqk,brnkhd->brnqhd', probs, vv.astype(jnp.float32))
    out = out.reshape(bn, rate, length, h, dh).transpose(0, 2, 1, 3, 4).reshape(bn, s_pad, h, dh)[:, :s]
    lse = lse.transpose(0, 1, 2, 4, 3).reshape(bn, rate, length, h)
    lse = lse.transpose(0, 2, 1, 3).reshape(bn, s_pad, h)[:, :s]
    return out, lse


def mixer_ab(h, w_in, sgu_g, sgu_b, sgu_w, sgu_bias, q_g, k_g, w_out):
    bn, s, _ = h.shape
    proj = h @ w_in
    a = jax.nn.gelu(proj[..., :2 * A_WIDTH], approximate=False)
    u, v = a[..., :A_WIDTH], a[..., A_WIDTH:]
    a_out = chunked_spatial_gating(u, layer_norm(v, sgu_g, sgu_b), sgu_w, sgu_bias)
    qkv = proj[..., 2 * A_WIDTH:].reshape(bn, s, 3, N_DIL, B_HEADS, B_HEAD_DIM)
    pos = jnp.arange(s, dtype=jnp.float32)
    outs, lses = [], []
    for g in range(N_DIL):
        q = apply_rope(rms_norm(qkv[:, :, 0, g], q_g[g]), pos)
        k = apply_rope(rms_norm(qkv[:, :, 1, g], k_g[g]), pos)
        o, l = dilated_group_attention(q, k, qkv[:, :, 2, g], DIL_RATES[g], DIL_WINDOWS[g] // DIL_RATES[g])
        outs.append(o)
        lses.append(l)
    wts = jax.nn.softmax(jnp.stack(lses), axis=0)
    b_out = jnp.sum(wts[..., None] * jnp.stack(outs), axis=0).astype(h.dtype).reshape(bn, s, B_WIDTH)
    return jnp.concatenate([a_out, b_out], axis=-1) @ w_out


def mixer_cd(h, w_in, conv_c_w, conv_c_b, c_ln_g, c_ln_b, conv_d_w, w_out):
    proj = h @ w_in
    c = proj[..., :C_WIDTH] * jax.nn.sigmoid(proj[..., C_WIDTH:2 * C_WIDTH])
    c = causal_depthwise_conv(c, conv_c_w) + conv_c_b.astype(c.dtype)
    c = jax.nn.silu(layer_norm(c, c_ln_g, c_ln_b))
    gate_b, gate_c, hv = jnp.split(proj[..., 2 * C_WIDTH:], 3, axis=-1)
    d = gate_b * causal_depthwise_conv(gate_c * hv, conv_d_w)
    return jnp.concatenate([c, d], axis=-1) @ w_out


def swiglu(h, w_gate, w_up, w_down):
    return (jax.nn.silu(h @ w_gate) * (h @ w_up)) @ w_down


def setup_inputs(seed: int = 0) -> dict:
    key = jax.random.key(seed)
    ks = jax.random.split(key, 24)
    f32 = jnp.float32

    def nrm(k, shape, scale):
        return jax.random.normal(k, shape, f32) * scale

    def gain(k, shape):
        return 1.0 + 0.05 * jax.random.normal(k, shape, f32)

    return {
        'x': jax.random.normal(ks[0], (BATCH, SEQ, D_MODEL), f32),
        'ab_norm_g': gain(ks[1], (N_AB, D_MODEL)),
        'ab_w_in': nrm(ks[2], (N_AB, D_MODEL, AB_IN), D_MODEL ** -0.5),
        'sgu_norm_g': gain(ks[3], (N_AB, A_WIDTH)),
        'sgu_norm_b': nrm(ks[4], (N_AB, A_WIDTH), 0.02),
        'sgu_w': nrm(ks[5], (N_AB, A_GROUPS, CHUNK, CHUNK), 0.5 * CHUNK ** -0.5),
        'sgu_bias': gain(ks[6], (N_AB, A_GROUPS, CHUNK)),
        'q_norm_g': gain(ks[7], (N_AB, N_DIL, B_HEAD_DIM)),
        'k_norm_g': gain(ks[8], (N_AB, N_DIL, B_HEAD_DIM)),
        'ab_w_out': nrm(ks[9], (N_AB, AB_OUT, D_MODEL), AB_OUT ** -0.5),
        'cd_norm_g': gain(ks[10], (N_CD, D_MODEL)),
        'cd_w_in': nrm(ks[11], (N_CD, D_MODEL, CD_IN), D_MODEL ** -0.5),
        'conv_c_w': nrm(ks[12], (N_CD, C_KERNEL, C_WIDTH), C_KERNEL ** -0.5),
        'conv_c_b': nrm(ks[13], (N_CD, C_WIDTH), 0.02),
        'c_ln_g': gain(ks[14], (N_CD, C_WIDTH)),
        'c_ln_b': nrm(ks[15], (N_CD, C_WIDTH), 0.02),
        'conv_d_w': nrm(ks[16], (N_CD, D_KERNEL, D_WIDTH), D_KERNEL ** -0.5),
        'cd_w_out': nrm(ks[17], (N_CD, CD_OUT, D_MODEL), CD_OUT ** -0.5),
        'ffn_norm_g': gain(ks[18], (DEPTH, D_MODEL)),
        'ffn_w_gate': nrm(ks[19], (DEPTH, D_MODEL, D_FF), D_MODEL ** -0.5),
        'ffn_w_up': nrm(ks[20], (DEPTH, D_MODEL, D_FF), D_MODEL ** -0.5),
        'ffn_w_down': nrm(ks[21], (DEPTH, D_FF, D_MODEL), D_FF ** -0.5),
    }


def reference(x, ab_norm_g, ab_w_in, sgu_norm_g, sgu_norm_b, sgu_w, sgu_bias, q_norm_g, k_norm_g,
              ab_w_out, cd_norm_g, cd_w_in, conv_c_w, conv_c_b, c_ln_g, c_ln_b, conv_d_w, cd_w_out,
              ffn_norm_g, ffn_w_gate, ffn_w_up, ffn_w_down):
    for layer in range(DEPTH):
        i = layer // 2
        if layer % 2 == 0:
            h = rms_norm(x, ab_norm_g[i])
            x = x + mixer_ab(h, ab_w_in[i], sgu_norm_g[i], sgu_norm_b[i], sgu_w[i], sgu_bias[i],
                             q_norm_g[i], k_norm_g[i], ab_w_out[i])
        else:
            h = rms_norm(x, cd_norm_g[i])
            x = x + mixer_cd(h, cd_w_in[i], conv_c_w[i], conv_c_b[i], c_ln_g[i], c_ln_b[i],
                             conv_d_w[i], cd_w_out[i])
        h = rms_norm(x, ffn_norm_g[layer])
        x = x + swiglu(h, ffn_w_gate[layer], ffn_w_up[layer], ffn_w_down[layer])
    return x
```

```cpp
#include <hip/hip_runtime.h>
#include <cstdio>
#include <cstdint>
namespace pg8 {
#define PG8_LAS __attribute__((address_space(3)))
typedef unsigned short bf16_t;
typedef short bf16x8 __attribute__((ext_vector_type(8)));
typedef float f32x4 __attribute__((ext_vector_type(4)));
typedef unsigned u32x4 __attribute__((ext_vector_type(4)));
constexpr int BM = 256, BK = 64, HALF = 128, HTB = HALF * BK * 2  , STAGE_BYTES = 8 * HTB, NXCD = 8, WGM = 8;

__host__ __device__ __forceinline__ int lds_byte(int r, int c) { const int st = (r >> 4) * 2 + (c >> 5), rr = r & 15, cc = c & 31, ob = rr * 64 + cc * 2; return st * 1024 + (ob ^ (((ob >> 9) & 1) << 5)); }
__host__ __device__ __forceinline__ void stage_rc(int b, int& R, int& C) { const int st = b / 1024, sb = b % 1024, swz = sb ^ (((sb >> 9) & 1) << 5); R = (st >> 1) * 16 + swz / 64; C = (st & 1) * 32 + (swz % 64) / 2; }
__host__ __device__ __forceinline__ int perm32(int rho) { const int n = rho >> 4, i = rho & 15; return 8 * (i >> 2) + 4 * n + (i & 3); }

struct Unit { int pm, pn; };
struct Gemm { const bf16_t* A; const bf16_t* Bt; int M, N, K; };

struct StaticOrder {
    int nM, nN, nwg, G, c;
    __host__ __device__ void init(int M, int N, int G_, int c_) { nM = M / BM; nN = N / BM; nwg = nM * nN; G = G_; c = c_; }
    __host__ __device__ bool next(int i, Unit& u) const {
        const long L = (long)i * G + c; if (L >= nwg) return false;
        int wgid = (int)L; { const int q = nwg / NXCD, r = nwg % NXCD, xcd = wgid % NXCD, off = wgid / NXCD; wgid = (xcd < r ? xcd * (q + 1) : r * (q + 1) + (xcd - r) * q) + off; }
        const int nig = WGM * nN, gid = wgid / nig, fm = gid * WGM, gsz = (nM - fm) < WGM ? (nM - fm) : WGM;
        u.pm = fm + ((wgid % nig) % gsz); u.pn = (wgid % nig) / gsz; return true;
    }
    __device__ __forceinline__ void a_ready(const Unit&) const {}
    __device__ __forceinline__ void done(const Unit&) const {}
};

__device__ __forceinline__ unsigned cvt_pk_bf16(float lo, float hi) { unsigned r; asm volatile("v_cvt_pk_bf16_f32 %0, %1, %2" : "=v"(r) : "v"(lo), "v"(hi)); return r; }
typedef float f32x2 __attribute__((ext_vector_type(2)));
__device__ __forceinline__ f32x2 gelu_pk(f32x2 v) {
    const f32x2 av = __builtin_elementwise_abs(v), d = av * 0.2316418882f + 1.0f;
    f32x2 t; t.x = __builtin_amdgcn_rcpf(d.x); t.y = __builtin_amdgcn_rcpf(d.y);
    f32x2 q = t * 0.5307027145f + (-0.7265760135f); q = q * t + 0.7107068705f; q = q * t + (-0.142248368f); q = q * t + 0.127414796f; q = q * t;
    const f32x2 s = (v * v) * (-0.72134752044f);
    f32x2 e; e.x = __builtin_amdgcn_exp2f(s.x); e.y = __builtin_amdgcn_exp2f(s.y);
    const f32x2 m = v * (q * e), r = v - m;
    f32x2 o; o.x = v.x < 0.f ? m.x : r.x; o.y = v.y < 0.f ? m.y : r.y; return o;
}
template <class Epi, class Sched, bool ALIGN_EPI = false, bool SP2 = false>
__device__ __forceinline__ void gemm_phase(PG8_LAS unsigned char* lds, const Gemm g, const Sched& S, const Epi& E) {
    const int tid = threadIdx.x, wid = __builtin_amdgcn_readfirstlane(tid >> 6), lane = tid & 63, wr = wid >> 2, wc = wid & 3, fr = lane & 15, fq = lane >> 4;
    const int K = g.K, nt = K / BK;
    unsigned voffA[2], voffB[2];
#pragma unroll
    for (int i = 0; i < 2; ++i) { int R, C; stage_rc(tid * 16 + i * 8192, R, C); const int Rb = Epi::PERM ? ((R & ~31) + perm32(R & 31)) : R;
        voffA[i] = (unsigned)(R * K + C) * 2u; voffB[i] = (unsigned)(Rb * K + C) * 2u; }
    const size_t kstep = (size_t)(BK * 2);
    const size_t hstep = (size_t)HALF * K * 2;
    const size_t tstep = 2 * hstep;
    const unsigned ldsw = (unsigned)wid * 1024u;
    const int aoff = lds_byte(wr * 64 + fr, fq * 8), boff = lds_byte(wc * 32 + fr, fq * 8);
#define PG8_SA(b, h) (((b) * 2 + (h)) * HTB)
#define PG8_SB(b, h) ((4 + (b) * 2 + (h)) * HTB)
#define PG8_STAGE(bufoff, gbase, voff) do { _Pragma("unroll") for (int _i = 0; _i < 2; ++_i) \
        __builtin_amdgcn_global_load_lds((const unsigned*)((const char*)(gbase) + (voff)[_i]), (PG8_LAS unsigned*)(lds + (bufoff) + ldsw + _i * 8192), 16, 0, 0); } while (0)
#define PG8_LDA(dst, b, h) do { _Pragma("unroll") for (int m = 0; m < 4; ++m) _Pragma("unroll") for (int k = 0; k < 2; ++k) dst[m][k] = *(const PG8_LAS bf16x8*)(lds + PG8_SA(b, h) + aoff + m * 2048 + k * 1024); } while (0)
#define PG8_LDB(dst, b, h) do { _Pragma("unroll") for (int n = 0; n < 2; ++n) _Pragma("unroll") for (int k = 0; k < 2; ++k) dst[n][k] = *(const PG8_LAS bf16x8*)(lds + PG8_SB(b, h) + boff + n * 2048 + k * 1024); } while (0)
#define PG8_MMA(ai, bj, At, Bt) do { __builtin_amdgcn_s_setprio(1); _Pragma("unroll") for (int m = 0; m < 4; ++m) _Pragma("unroll") for (int n = 0; n < 2; ++n) _Pragma("unroll") for (int k = 0; k < 2; ++k) \
        acc[ai][bj][m][n] = __builtin_amdgcn_mfma_f32_16x16x32_bf16(Bt[n][k], At[m][k], acc[ai][bj][m][n], 0, 0, 0); __builtin_amdgcn_s_setprio(0); } while (0)
#define PG8_WAIT_V(n) asm volatile("s_waitcnt vmcnt(" #n ")" ::: "memory")
#define PG8_WAIT_L(n) asm volatile("s_waitcnt lgkmcnt(" #n ")" ::: "memory")
#define PG8_BAR __builtin_amdgcn_s_barrier()
#define PG8_SCHED __builtin_amdgcn_sched_barrier(0)
    Unit cur, nxt; int ui = 0;
    if (!S.next(0, cur)) return;
    f32x4 acc[2][2][4][2];
#pragma unroll
    for (int a = 0; a < 2; ++a)
#pragma unroll
        for (int b = 0; b < 2; ++b)
#pragma unroll
            for (int m = 0; m < 4; ++m)
#pragma unroll
                for (int n = 0; n < 2; ++n) acc[a][b][m][n] = (f32x4){0.f, 0.f, 0.f, 0.f};
    bf16x8 At[4][2], B0[2][2], B1[2][2];
    const char* cA = (const char*)g.A + (size_t)cur.pm * tstep; const char* cB = (const char*)g.Bt + (size_t)cur.pn * tstep;
    S.a_ready(cur);
    if constexpr (SP2) {
        PG8_STAGE(PG8_SB(0, 0), cB, voffB); PG8_STAGE(PG8_SB(0, 1), cB + hstep, voffB); PG8_STAGE(PG8_SA(0, 0), cA, voffA); PG8_STAGE(PG8_SA(0, 1), cA + hstep, voffA);
        if (wr == 1) PG8_BAR;
        PG8_WAIT_V(2); PG8_BAR;
        PG8_STAGE(PG8_SB(1, 0), cB + kstep, voffB); PG8_STAGE(PG8_SA(1, 0), cA + kstep, voffA); PG8_STAGE(PG8_SB(1, 1), cB + hstep + kstep, voffB);
        PG8_WAIT_V(6); PG8_BAR;
    } else {
        PG8_STAGE(PG8_SB(0, 0), cB, voffB); PG8_STAGE(PG8_SA(0, 0), cA, voffA); PG8_STAGE(PG8_SB(0, 1), cB + hstep, voffB); PG8_STAGE(PG8_SA(0, 1), cA + hstep, voffA);
        if (wr == 1) PG8_BAR;
        PG8_WAIT_V(4); PG8_BAR;
        PG8_STAGE(PG8_SB(1, 0), cB + kstep, voffB); PG8_STAGE(PG8_SA(1, 0), cA + kstep, voffA); PG8_STAGE(PG8_SB(1, 1), cB + hstep + kstep, voffB);
        PG8_WAIT_V(6); PG8_BAR;
    }
    for (;;) {
        const bool has_next = S.next(ui + 1, nxt);
        const char* nA = has_next ? (const char*)g.A + (size_t)nxt.pm * tstep : cA; const char* nB = has_next ? (const char*)g.Bt + (size_t)nxt.pn * tstep : cB;
        for (int t = 0; t < nt; t += 2) {
            const bool last = (t == nt - 2);
            const char* a1 = cA + (size_t)(t + 1) * kstep;
            const char* a2 = last ? nA : cA + (size_t)(t + 2) * kstep; const char* b2 = last ? nB : cB + (size_t)(t + 2) * kstep;
            const char* a3 = a2 + kstep; const char* b3 = b2 + kstep;
            if (last && has_next) S.a_ready(nxt);
            if constexpr (SP2) {
            PG8_LDB(B0, 0, 0); PG8_LDB(B1, 0, 1); PG8_SCHED; PG8_LDA(At, 0, 0); PG8_STAGE(PG8_SA(1, 1), a1 + hstep, voffA);
            PG8_WAIT_V(8); PG8_WAIT_L(0); PG8_BAR; PG8_MMA(0, 0, At, B0); PG8_MMA(0, 1, At, B1); PG8_BAR; PG8_SCHED;
            PG8_LDA(At, 0, 1); PG8_STAGE(PG8_SB(0, 0), b2, voffB); PG8_STAGE(PG8_SB(0, 1), b2 + hstep, voffB); PG8_STAGE(PG8_SA(0, 0), a2, voffA);
            PG8_WAIT_V(8); PG8_WAIT_L(0); PG8_BAR; PG8_MMA(1, 0, At, B0); PG8_MMA(1, 1, At, B1); PG8_BAR; PG8_SCHED;
            PG8_LDB(B0, 1, 0); PG8_LDB(B1, 1, 1); PG8_SCHED; PG8_LDA(At, 1, 0); PG8_STAGE(PG8_SA(0, 1), a2 + hstep, voffA);
            PG8_WAIT_V(8); PG8_WAIT_L(0); PG8_BAR; PG8_MMA(0, 0, At, B0); PG8_MMA(0, 1, At, B1); PG8_BAR; PG8_SCHED;
            PG8_LDA(At, 1, 1); PG8_STAGE(PG8_SB(1, 0), b3, voffB); PG8_STAGE(PG8_SB(1, 1), b3 + hstep, voffB); PG8_STAGE(PG8_SA(1, 0), a3, voffA);
            PG8_WAIT_V(8); PG8_WAIT_L(0); PG8_BAR; PG8_MMA(1, 0, At, B0); PG8_MMA(1, 1, At, B1); PG8_BAR; PG8_SCHED;
            } else {
            PG8_LDB(B0, 0, 0); PG8_SCHED; PG8_LDA(At, 0, 0); PG8_STAGE(PG8_SA(1, 1), a1 + hstep, voffA);
            PG8_WAIT_L(8); PG8_BAR; PG8_WAIT_L(0); PG8_MMA(0, 0, At, B0); PG8_BAR; PG8_SCHED;
            PG8_LDB(B1, 0, 1); PG8_STAGE(PG8_SB(0, 0), b2, voffB);
            PG8_BAR; PG8_WAIT_L(0); PG8_MMA(0, 1, At, B1); PG8_BAR;
            PG8_LDA(At, 0, 1); PG8_STAGE(PG8_SA(0, 0), a2, voffA);
            PG8_BAR; PG8_WAIT_L(0); PG8_MMA(1, 0, At, B0); PG8_BAR; PG8_SCHED;
            PG8_STAGE(PG8_SB(0, 1), b2 + hstep, voffB);
            PG8_WAIT_V(6); PG8_BAR; PG8_MMA(1, 1, At, B1); PG8_BAR;
            PG8_LDB(B0, 1, 0); PG8_SCHED; PG8_LDA(At, 1, 0); PG8_STAGE(PG8_SA(0, 1), a2 + hstep, voffA);
            PG8_WAIT_L(8); PG8_BAR; PG8_WAIT_L(0); PG8_MMA(0, 0, At, B0); PG8_BAR; PG8_SCHED;
            PG8_LDB(B1, 1, 1); PG8_STAGE(PG8_SB(1, 0), b3, voffB);
            PG8_BAR; PG8_WAIT_L(0); PG8_MMA(0, 1, At, B1); PG8_BAR;
            PG8_LDA(At, 1, 1); PG8_STAGE(PG8_SA(1, 0), a3, voffA);
            PG8_BAR; PG8_WAIT_L(0); PG8_MMA(1, 0, At, B0); PG8_BAR; PG8_SCHED;
            PG8_STAGE(PG8_SB(1, 1), b3 + hstep, voffB);
            PG8_WAIT_V(6); PG8_BAR; PG8_MMA(1, 1, At, B1); PG8_BAR;
            }
        }
        if constexpr (ALIGN_EPI) { if (wr == 0) PG8_BAR; }
        if constexpr (!Epi::AFTER_DRAIN) { E(acc, cur, wr, wc, fr, fq); S.done(cur); }
        if (!has_next) break;
#pragma unroll
        for (int a = 0; a < 2; ++a)
#pragma unroll
            for (int b = 0; b < 2; ++b)
#pragma unroll
                for (int m = 0; m < 4; ++m)
#pragma unroll
                    for (int n = 0; n < 2; ++n) acc[a][b][m][n] = (f32x4){0.f, 0.f, 0.f, 0.f};
        cur = nxt; cA = nA; cB = nB; ++ui;
        if constexpr (ALIGN_EPI) { if (wr == 1) PG8_BAR; }
    }
    PG8_WAIT_V(0);
    if constexpr (!ALIGN_EPI) { if (wr == 0) PG8_BAR; }
    PG8_BAR;
    if constexpr (Epi::AFTER_DRAIN) { E.fused(acc, cur, wr, wc, fr, fq, lds, wid, lane); S.done(cur); }
#undef PG8_SA
#undef PG8_SB
#undef PG8_STAGE
#undef PG8_LDA
#undef PG8_LDB
#undef PG8_MMA
#undef PG8_WAIT_V
#undef PG8_WAIT_L
#undef PG8_BAR
#undef PG8_SCHED
}
}
namespace pg8 {
constexpr float NORM_EPS = 1e-6f;
typedef unsigned u32x2 __attribute__((ext_vector_type(2)));
__device__ __forceinline__ float sigmoid_f(float x) { return __builtin_amdgcn_rcpf(1.0f + __builtin_amdgcn_exp2f(-1.4426950408889634f * x)); }
__device__ __forceinline__ u32x4 pack8(const f32x4 a, const f32x4 b) { u32x4 w; w.x = cvt_pk_bf16(a[0], a[1]); w.y = cvt_pk_bf16(a[2], a[3]); w.z = cvt_pk_bf16(b[0], b[1]); w.w = cvt_pk_bf16(b[2], b[3]); return w; }
__device__ __forceinline__ float dot4(const f32x4 a) { return (a[0] * a[0] + a[1] * a[1]) + (a[2] * a[2] + a[3] * a[3]); }

struct EpiRes {
    static constexpr bool PERM = true, AFTER_DRAIN = false;
    const float* base; float* out; bf16_t* xb; float* rowss;
    __device__ __forceinline__ void operator()(const f32x4 (&acc)[2][2][4][2], const Unit& u, int wr, int wc, int fr, int fq) const {
        const int row0 = u.pm * BM + wr * 64 + fr, col0 = u.pn * BM + wc * 32 + 8 * fq;
#pragma unroll
        for (int ai = 0; ai < 2; ++ai)
#pragma unroll
            for (int m = 0; m < 4; ++m) {
                const int row = row0 + ai * HALF + m * 16; const size_t off = (size_t)row * 1024 + col0; float ss = 0.f;
#pragma unroll
                for (int bj = 0; bj < 2; ++bj) {
                    const f32x4 b0 = *(const f32x4*)(base + off + bj * HALF), b1 = *(const f32x4*)(base + off + bj * HALF + 4);
                    const f32x4 v0 = acc[ai][bj][m][0] + b0, v1 = acc[ai][bj][m][1] + b1;
                    *(f32x4*)(out + off + bj * HALF) = v0; *(f32x4*)(out + off + bj * HALF + 4) = v1;
                    if (xb) *(u32x4*)(xb + off + bj * HALF) = pack8(v0, v1);
                    ss += dot4(v0) + dot4(v1);
                }
                if (rowss) { ss += __shfl_xor(ss, 16); ss += __shfl_xor(ss, 32); if (fq == 0) atomicAdd(rowss + row, ss); }
                if (m & 1) asm volatile("" ::: "memory");
            }
    }
};

struct EpiGU {
    static constexpr bool PERM = true, AFTER_DRAIN = false;
    const float* rowss; bf16_t* act; int ldc;
    __device__ __forceinline__ void operator()(const f32x4 (&acc)[2][2][4][2], const Unit& u, int wr, int wc, int fr, int fq) const {
        const int row0 = u.pm * BM + wr * 64 + fr, col0 = u.pn * HALF + wc * 32 + 8 * fq;
#pragma unroll
        for (int ai = 0; ai < 2; ++ai)
#pragma unroll
            for (int m = 0; m < 4; ++m) {
                const int row = row0 + ai * HALF + m * 16; const float rs = __builtin_amdgcn_rsqf(rowss[row] * (1.0f / 1024.0f) + NORM_EPS);
                f32x4 o[2];
#pragma unroll
                for (int n = 0; n < 2; ++n) { const f32x4 g = acc[ai][0][m][n] * rs, up = acc[ai][1][m][n] * rs;
#pragma unroll
                    for (int e = 0; e < 4; ++e) o[n][e] = g[e] * sigmoid_f(g[e]) * up[e]; }
                *(u32x4*)(act + (size_t)row * ldc + col0) = pack8(o[0], o[1]);
            }
    }
};

struct EpiIn0 {
    static constexpr bool PERM = true, AFTER_DRAIN = false;
    const float* rowss; bf16_t* UV; bf16_t* Qb; bf16_t* Kb; bf16_t* Vb; const float* qg; const float* kg; const float* rope;
    __device__ __forceinline__ void operator()(const f32x4 (&acc)[2][2][4][2], const Unit& u, int wr, int wc, int fr, int fq) const {
        const int row0 = u.pm * BM + wr * 64 + fr, pn = u.pn;
        if (pn < 4) {
            const int col0 = pn * BM + wc * 32 + 8 * fq;
#pragma unroll
            for (int ai = 0; ai < 2; ++ai)
#pragma unroll
                for (int m = 0; m < 4; ++m) {
                    const int row = row0 + ai * HALF + m * 16; const float rs = __builtin_amdgcn_rsqf(rowss[row] * (1.0f / 1024.0f) + NORM_EPS);
#pragma unroll
                    for (int bj = 0; bj < 2; ++bj) { f32x4 v0 = acc[ai][bj][m][0] * rs, v1 = acc[ai][bj][m][1] * rs;
                        const f32x2 a = gelu_pk((f32x2){v0[0], v0[1]}), b = gelu_pk((f32x2){v0[2], v0[3]}), c = gelu_pk((f32x2){v1[0], v1[1]}), d = gelu_pk((f32x2){v1[2], v1[3]});
                        v0 = (f32x4){a.x, a.y, b.x, b.y}; v1 = (f32x4){c.x, c.y, d.x, d.y};
                        *(u32x4*)(UV + (size_t)row * 1024 + col0 + bj * HALF) = pack8(v0, v1); }
                }
        } else if (pn < 16) {
            const int t = pn - 4, isk = t >= 6 ? 1 : 0, tt = t - 6 * isk, g = tt >> 1, head = 4 * (tt & 1) + wc;
            bf16_t* dst = (isk ? Kb : Qb) + g * 512 + head * 64 + 8 * fq;
            const float* gp = (isk ? kg : qg) + g * 64 + 8 * fq;
            const f32x4 g00 = *(const f32x4*)(gp), g01 = *(const f32x4*)(gp + 4), g10 = *(const f32x4*)(gp + 32), g11 = *(const f32x4*)(gp + 36);
            const float osc = isk ? 1.0f : 0.125f * 1.4426950408889634f;
#pragma unroll
            for (int ai = 0; ai < 2; ++ai)
#pragma unroll
                for (int m = 0; m < 4; ++m) {
                    const int row = row0 + ai * HALF + m * 16; const float rs = __builtin_amdgcn_rsqf(rowss[row] * (1.0f / 1024.0f) + NORM_EPS);
                    f32x4 a0 = acc[ai][0][m][0] * rs, a1 = acc[ai][0][m][1] * rs, b0 = acc[ai][1][m][0] * rs, b1 = acc[ai][1][m][1] * rs;
                    float ss = (dot4(a0) + dot4(a1)) + (dot4(b0) + dot4(b1));
                    ss += __shfl_xor(ss, 16); ss += __shfl_xor(ss, 32);
                    const float rn = __builtin_amdgcn_rsqf(ss * (1.0f / 64.0f) + NORM_EPS);
                    a0 = a0 * rn * g00; a1 = a1 * rn * g01; b0 = b0 * rn * g10; b1 = b1 * rn * g11;
                    const float* rp = rope + (size_t)(row & 4095) * 16;
                    const f32x4 r0 = *(const f32x4*)(rp), r1 = *(const f32x4*)(rp + 4), r2 = *(const f32x4*)(rp + 8), r3 = *(const f32x4*)(rp + 12);
                    const float cs[8] = {r0[0], r0[2], r1[0], r1[2], r2[0], r2[2], r3[0], r3[2]}, sn[8] = {r0[1], r0[3], r1[1], r1[3], r2[1], r2[3], r3[1], r3[3]};
                    float mine[8] = {a0[0], a0[1], a0[2], a0[3], a1[0], a1[1], a1[2], a1[3]};
#pragma unroll
                    for (int i = 0; i < 8; ++i) { const float oth = __shfl_xor(mine[i], 16);
                        const float rot = (fq == 0) ? (mine[i] * cs[i] - oth * sn[i]) : (oth * sn[i] + mine[i] * cs[i]);
                        mine[i] = (fq < 2) ? rot : mine[i]; }
                    a0 = (f32x4){mine[0], mine[1], mine[2], mine[3]}; a1 = (f32x4){mine[4], mine[5], mine[6], mine[7]};
                    a0 = a0 * osc; a1 = a1 * osc; b0 = b0 * osc; b1 = b1 * osc;
                    bf16_t* rowp = dst + (size_t)row * 1536;
                    *(u32x4*)(rowp) = pack8(a0, a1); *(u32x4*)(rowp + 32) = pack8(b0, b1);
                }
        } else {
            const int col0 = (pn - 16) * BM + wc * 32 + 8 * fq;
#pragma unroll
            for (int ai = 0; ai < 2; ++ai)
#pragma unroll
                for (int m = 0; m < 4; ++m) {
                    const int row = row0 + ai * HALF + m * 16; const float rs = __builtin_amdgcn_rsqf(rowss[row] * (1.0f / 1024.0f) + NORM_EPS);
#pragma unroll
                    for (int bj = 0; bj < 2; ++bj) *(u32x4*)(Vb + (size_t)row * 1536 + col0 + bj * HALF) = pack8(acc[ai][bj][m][0] * rs, acc[ai][bj][m][1] * rs);
                }
        }
    }
};

struct EpiIn1 {
    static constexpr bool PERM = true, AFTER_DRAIN = false;
    const float* rowss; bf16_t* P1;
    __device__ __forceinline__ void operator()(const f32x4 (&acc)[2][2][4][2], const Unit& u, int wr, int wc, int fr, int fq) const {
        const int row0 = u.pm * BM + wr * 64 + fr, pn = u.pn;
#pragma unroll
        for (int ai = 0; ai < 2; ++ai)
#pragma unroll
            for (int m = 0; m < 4; ++m) {
                const int row = row0 + ai * HALF + m * 16; const float rs = __builtin_amdgcn_rsqf(rowss[row] * (1.0f / 1024.0f) + NORM_EPS);
                bf16_t* rowp = P1 + (size_t)row * 1536 + wc * 32 + 8 * fq;
                if (pn < 4) { f32x4 o[2];
#pragma unroll
                    for (int n = 0; n < 2; ++n) { const f32x4 a = acc[ai][0][m][n] * rs, gt = acc[ai][1][m][n] * rs;
#pragma unroll
                        for (int e = 0; e < 4; ++e) o[n][e] = a[e] * sigmoid_f(gt[e]); }
                    *(u32x4*)(rowp + pn * HALF) = pack8(o[0], o[1]);
                } else if (pn < 6) {
#pragma unroll
                    for (int bj = 0; bj < 2; ++bj) *(u32x4*)(rowp + 512 + (pn - 4) * BM + bj * HALF) = pack8(acc[ai][bj][m][0] * rs, acc[ai][bj][m][1] * rs);
                } else { f32x4 o[2];
#pragma unroll
                    for (int n = 0; n < 2; ++n) o[n] = (acc[ai][0][m][n] * rs) * (acc[ai][1][m][n] * rs);
                    *(u32x4*)(rowp + 1024 + (pn - 6) * HALF) = pack8(o[0], o[1]);
                }
            }
    }
};
}

constexpr int NWAVES = 8;
constexpr int BATCH = 8, SEQ = 4096, DM = 1024, T = BATCH * SEQ;
constexpr int AB_IN = 5632, CD_IN = 2560, DFF = 2816, GU_N = 2 * DFF;
constexpr size_t MiB = 1u << 20;
constexpr size_t WS_CTL = 0, CTL_ZERO_BYTES = 1 * MiB;
constexpr size_t WS_ROPE = 1 * MiB;
constexpr size_t WS_WSG = WS_ROPE + 256 * 1024;
constexpr size_t WS_RSS = WS_WSG + 128 * 1024;
constexpr size_t WS_LSE = 2 * MiB;
constexpr size_t WS_W0IN = 8 * MiB;
constexpr size_t WS_W0OUT = 19 * MiB;
constexpr size_t WS_W0GU = 21 * MiB;
constexpr size_t WS_W0D = 32 * MiB;
constexpr size_t WS_W1IN = 38 * MiB;
constexpr size_t WS_W1OUT = 43 * MiB;
constexpr size_t WS_W1GU = 45 * MiB;
constexpr size_t WS_W1D = 56 * MiB;
constexpr size_t WS_XB = 64 * MiB;
constexpr size_t WS_UV = 128 * MiB;
constexpr size_t WS_Q = 192 * MiB;
constexpr size_t WS_K = 288 * MiB;
constexpr size_t WS_V = 384 * MiB;
constexpr size_t WS_ACT = WS_Q;
constexpr size_t WS_P1 = 368 * MiB;
constexpr size_t WS_AB = WS_K, WS_CD = WS_UV;
constexpr size_t WS_END = 480 * MiB;
constexpr int CW_BAR = 4096;

constexpr int RING_OFF = 0, RING_BYTES = 131072;
constexpr int LDSCTL_OFF = RING_BYTES, MISC_OFF = LDSCTL_OFF + 320;
constexpr int AUX_OFF = LDSCTL_OFF + 1024;
constexpr int LDS_BYTES = 147456;
#define GAS __attribute__((address_space(1)))
#define LAS __attribute__((address_space(3)))
typedef unsigned short bf16;
typedef unsigned v4u __attribute__((ext_vector_type(4)));
typedef float f32x4 __attribute__((ext_vector_type(4)));
typedef short bf16x8 __attribute__((ext_vector_type(8)));
typedef GAS unsigned gu32;
typedef GAS unsigned long long gu64;
#define RLX_AGENT __ATOMIC_RELAXED, __HIP_MEMORY_SCOPE_AGENT
#define LDS_WAIT() asm volatile("s_waitcnt lgkmcnt(0)" ::: "memory")
#define VM_WAIT() asm volatile("s_waitcnt vmcnt(0)" ::: "memory")
__device__ __forceinline__ unsigned long long rt() { return __builtin_amdgcn_s_memrealtime(); }
__device__ __forceinline__ unsigned f2bf(float f) { unsigned u = __builtin_bit_cast(unsigned, f); return (u + 0x7fffu + ((u >> 16) & 1u)) >> 16; }
__device__ __forceinline__ unsigned pk2(float lo, float hi) { return f2bf(lo) | (f2bf(hi) << 16); }

#define XB_TMO      128
#define XB_XCNT(j)  (256  + 64 * (j))
#define XB_XSUB(j)  (1280 + 64 * (j))
#define XB_XGEN(j)  (2304 + 64 * (j))
#define XB_TOP      3328
#define XB_TOPGEN   3392
#define XCD_BAR_WORDS 3456
#define XB_SPIN_CAP (1u << 18)

__device__ __forceinline__ unsigned xb_ld(unsigned* p)              { return __hip_atomic_load(p, __ATOMIC_RELAXED, __HIP_MEMORY_SCOPE_AGENT); }
__device__ __forceinline__ unsigned xb_add(unsigned* p, unsigned v) { return __hip_atomic_fetch_add(p, v, __ATOMIC_RELAXED, __HIP_MEMORY_SCOPE_AGENT); }
__device__ __forceinline__ unsigned xb_xcc_id() { return (unsigned)__builtin_amdgcn_s_getreg((3 << 11) | 20) & 0xFu; }
#define XB_SPIN(cond, bar) do { unsigned _sp = 0; while (cond) { __builtin_amdgcn_s_sleep(1); \
    if ((++_sp & 255u) == 0u) { if (xb_ld(&(bar)[XB_TMO])) break; if (_sp > XB_SPIN_CAP) { atomicAdd(&(bar)[XB_TMO], 1u); break; } } } } while (0)

struct XcdBarrier {
    unsigned* bar; unsigned x;
    volatile LAS unsigned* st;
};

__device__ __forceinline__ XcdBarrier xcd_barrier_post(unsigned* bar, volatile LAS unsigned* st) {
    XcdBarrier b; b.bar = bar; b.x = xb_xcc_id(); b.st = st;
    if (threadIdx.x == 0) (void)xb_add(&bar[XB_XCNT(b.x)], 1u);
    return b;
}
__device__ __forceinline__ void xcd_barrier_complete(unsigned* bar, unsigned x, unsigned& nloc, unsigned& nx) {
    const unsigned G = gridDim.x * gridDim.y * gridDim.z;
    unsigned sum, cnt, mine, sp = 0u;
    for (;;) {
        sum = 0u; cnt = 0u; mine = 0u;
#pragma unroll
        for (unsigned j = 0; j < 16; ++j) { const unsigned c = xb_ld(&bar[XB_XCNT(j)]); sum += c; cnt += (c > 0u) ? 1u : 0u; mine = (j == x) ? c : mine; }
        if (sum == G) break;
        __builtin_amdgcn_s_sleep(1);
        if ((++sp & 255u) == 0u) { if (xb_ld(&bar[XB_TMO])) break; if (sp > XB_SPIN_CAP) { atomicAdd(&bar[XB_TMO], 1u); break; } }
    }
    nloc = mine > 0u ? mine : 1u; nx = cnt > 0u ? cnt : 1u;
}

__device__ __forceinline__ void xcd_barrier(const XcdBarrier& b) {
    asm volatile("s_waitcnt vmcnt(0)" ::: "memory");
    __syncthreads();
    if (threadIdx.x == 0) {
        unsigned* bar = b.bar;
        __builtin_amdgcn_s_waitcnt(0);
        unsigned nloc = b.st[0], nx = b.st[1];
        if (nloc == 0u) { xcd_barrier_complete(bar, b.x, nloc, nx); b.st[0] = nloc; b.st[1] = nx; }
        const unsigned old = xb_add(&bar[XB_XSUB(b.x)], 1u);
        const unsigned gen = old / nloc;
        if (old + 1u == (gen + 1u) * nloc) {
            __builtin_amdgcn_fence(__ATOMIC_RELEASE, "agent");
            asm volatile("s_waitcnt vmcnt(0)" ::: "memory");
            const unsigned og = xb_add(&bar[XB_TOP], 1u);
            const unsigned tg = og / nx;
            if (og + 1u == (tg + 1u) * nx) xb_add(&bar[XB_TOPGEN], 1u);
            else XB_SPIN(xb_ld(&bar[XB_TOPGEN]) == tg, bar);
            __builtin_amdgcn_fence(__ATOMIC_ACQUIRE, "agent");
            xb_add(&bar[XB_XGEN(b.x)], 1u);
            asm volatile("s_waitcnt vmcnt(0)" ::: "memory");
        } else {
            XB_SPIN(xb_ld(&bar[XB_XGEN(b.x)]) == gen, bar);
            __builtin_amdgcn_fence(__ATOMIC_ACQUIRE, "agent");
            asm volatile("s_waitcnt vmcnt(0)" ::: "memory");
        }
    }
    __syncthreads();
}

typedef unsigned u32x2 __attribute__((ext_vector_type(2)));
typedef float f32x16 __attribute__((ext_vector_type(16)));
typedef short s16x4 __attribute__((ext_vector_type(4)));
struct Frame {
    LAS unsigned char* lds;
    volatile LAS unsigned* MISC;
    gu32* ctl;
    int tid, lane, wave;
    int vcu, G;
    const float* in[22];
    float* out;
    unsigned char* ws;
};
__device__ __forceinline__ float wave_sum(float v) {
#pragma unroll
    for (int o = 1; o < 64; o <<= 1) v += __shfl_xor(v, o);
    return v;
}
__device__ __forceinline__ unsigned cvtpk_s(float lo, float hi) { typedef float f2_t __attribute__((ext_vector_type(2))); typedef __bf16 b2_t __attribute__((ext_vector_type(2)));
    f2_t v = {lo, hi}; b2_t b = __builtin_convertvector(v, b2_t); return __builtin_bit_cast(unsigned, b); }
__device__ __forceinline__ float bf_lo(unsigned w) { return __builtin_bit_cast(float, w << 16); }
__device__ __forceinline__ float bf_hi(unsigned w) { return __builtin_bit_cast(float, w & 0xffff0000u); }

__device__ __forceinline__ void p0_item(const float* W, int K, int N, int k0, int n0, bf16* WT, int drow0, const float* gain, LAS float* scr, int lane) {
#pragma unroll 8
    for (int i = 0; i < 32; ++i) { const int kk = 2 * i + (lane >> 5); float w = W[(size_t)(k0 + kk) * N + n0 + (lane & 31)]; if (gain) w *= gain[k0 + kk]; scr[kk * 33 + (lane & 31)] = w; }
    LDS_WAIT(); asm volatile("" ::: "memory");
    const int c = lane & 7;
#pragma unroll
    for (int j = 0; j < 4; ++j) { const int n = (lane >> 3) + 8 * j; const LAS float* s = scr + (8 * c) * 33 + n;
        v4u o; o.x = pk2(s[0 * 33], s[1 * 33]); o.y = pk2(s[2 * 33], s[3 * 33]); o.z = pk2(s[4 * 33], s[5 * 33]); o.w = pk2(s[6 * 33], s[7 * 33]);
        *(GAS v4u*)(WT + (size_t)(drow0 + n) * K + k0 + 8 * c) = o; }
    LDS_WAIT(); asm volatile("" ::: "memory");
}
__device__ __forceinline__ void p0_prologue(Frame& F) {
    LAS float* scr = (LAS float*)(F.lds + RING_OFF + F.wave * 16384);
    const int gw = F.vcu * NWAVES + F.wave, NGW = F.G * NWAVES, lane = F.lane;
    unsigned char* ws = F.ws;
    constexpr int I_IN0 = 16 * (AB_IN / 32), I_SQ = 16 * 32, I_GU = 16 * (DFF / 32), I_DN = (DFF / 64) * 32, I_IN1 = 16 * (CD_IN / 32);
    constexpr int NITEMS = I_IN0 + I_SQ + 2 * I_GU + I_DN + I_IN1 + I_SQ + 2 * I_GU + I_DN;
    for (int it = gw; it < NITEMS; it += NGW) {
        int r = it;
        if (r < I_IN0) {
            const int nblk = AB_IN / 32, k0 = 64 * (r / nblk), n0 = 32 * (r % nblk); int dr = n0;
            if (n0 >= 1024 && n0 < 4096) { const int cc = n0 - 1024, tile = cc >> 8, o = cc & 255, wc = o >> 6, bj = (o >> 5) & 1; dr = 1024 + tile * 256 + bj * 128 + wc * 32; }
            p0_item(F.in[2], 1024, AB_IN, k0, n0, (bf16*)(ws + WS_W0IN), dr, F.in[1], scr, lane); continue; }
        r -= I_IN0;
        if (r < I_SQ) { p0_item(F.in[9], 1024, 1024, 64 * (r / 32), 32 * (r % 32), (bf16*)(ws + WS_W0OUT), 32 * (r % 32), nullptr, scr, lane); continue; }
        r -= I_SQ;
        if (r < 2 * I_GU) { const int up = r >= I_GU ? 1 : 0; r -= up * I_GU; const int nblk = DFF / 32, k0 = 64 * (r / nblk), n0 = 32 * (r % nblk);
            p0_item(F.in[up ? 20 : 19], 1024, DFF, k0, n0, (bf16*)(ws + WS_W0GU), 256 * (n0 >> 7) + (n0 & 127) + 128 * up, F.in[18], scr, lane); continue; }
        r -= 2 * I_GU;
        if (r < I_DN) { p0_item(F.in[21], DFF, 1024, 64 * (r / 32), 32 * (r % 32), (bf16*)(ws + WS_W0D), 32 * (r % 32), nullptr, scr, lane); continue; }
        r -= I_DN;
        if (r < I_IN1) {
            const int nblk = CD_IN / 32, k0 = 64 * (r / nblk), n0 = 32 * (r % nblk); int dr;
            if (n0 < 512) dr = 256 * (n0 >> 7) + (n0 & 127);
            else if (n0 < 1024) { const int n1 = n0 - 512; dr = 256 * (n1 >> 7) + 128 + (n1 & 127); }
            else if (n0 < 1536) dr = n0;
            else if (n0 < 2048) { const int n1 = n0 - 1536; dr = 1536 + 256 * (n1 >> 7) + (n1 & 127); }
            else { const int n1 = n0 - 2048; dr = 1536 + 256 * (n1 >> 7) + 128 + (n1 & 127); }
            p0_item(F.in[11], 1024, CD_IN, k0, n0, (bf16*)(ws + WS_W1IN), dr, F.in[10], scr, lane); continue; }
        r -= I_IN1;
        if (r < I_SQ) { p0_item(F.in[17], 1024, 1024, 64 * (r / 32), 32 * (r % 32), (bf16*)(ws + WS_W1OUT), 32 * (r % 32), nullptr, scr, lane); continue; }
        r -= I_SQ;
        if (r < 2 * I_GU) { const int up = r >= I_GU ? 1 : 0; r -= up * I_GU; const int nblk = DFF / 32, k0 = 64 * (r / nblk), n0 = 32 * (r % nblk);
            p0_item((up ? F.in[20] : F.in[19]) + (size_t)1024 * DFF, 1024, DFF, k0, n0, (bf16*)(ws + WS_W1GU), 256 * (n0 >> 7) + (n0 & 127) + 128 * up, F.in[18] + 1024, scr, lane); continue; }
        r -= 2 * I_GU;
        p0_item(F.in[21] + (size_t)DFF * 1024, DFF, 1024, 64 * (r / 32), 32 * (r % 32), (bf16*)(ws + WS_W1D), 32 * (r % 32), nullptr, scr, lane);
    }
    float* rss = (float*)(ws + WS_RSS); bf16* XB = (bf16*)(ws + WS_XB);
    for (int m = gw; m < T; m += NGW) {
        const GAS f32x4* xr = (const GAS f32x4*)(F.in[0] + (size_t)m * DM) + lane; f32x4 v[4]; float s = 0.f;
#pragma unroll
        for (int j = 0; j < 4; ++j) { v[j] = xr[64 * j]; s += (v[j].x * v[j].x + v[j].y * v[j].y) + (v[j].z * v[j].z + v[j].w * v[j].w); }
        s = wave_sum(s); if (lane == 0) rss[m] = s;
        GAS unsigned long long* o8 = (GAS unsigned long long*)(XB + (size_t)m * DM) + lane;
#pragma unroll
        for (int j = 0; j < 4; ++j) o8[64 * j] = (unsigned long long)pk2(v[j].x, v[j].y) | ((unsigned long long)pk2(v[j].z, v[j].w) << 32);
    }
    const int gt = gw * 64 + lane, NGT = NGW * 64;
    for (int i = gt; i < 3 * T; i += NGT) rss[T + i] = 0.f;
    float* rope = (float*)(ws + WS_ROPE);
    for (int i = gt; i < SEQ * 8; i += NGT) { const int pos = i >> 3, k = i & 7; const float inv = exp2f(-2.3664460711655218f * (float)k), ang = (float)pos * inv;
        rope[2 * i] = cosf(ang); rope[2 * i + 1] = sinf(ang); }
    bf16* wsg = (bf16*)(ws + WS_WSG); const float* sw = F.in[5];
    for (int i = gt; i < 4 * 128 * 128; i += NGT) { const int t = (i >> 7) & 127, s = i & 127; wsg[i] = (bf16)(s <= t ? f2bf(sw[i]) : 0u); }
}

namespace att {
constexpr int KCH = 6160, LDS_KO = 0, LDS_VO = 8 * KCH, NUNITS = 3 * BATCH * 8 * 16;
__device__ __forceinline__ s16x4 vtr(const LAS unsigned char* p) { return __builtin_bit_cast(s16x4, __builtin_amdgcn_ds_read_tr16_b64_v4i16((LAS s16x4*)p)); }
__device__ __forceinline__ void attn_unit(LAS unsigned char* lds, int U, bf16* Qb, const bf16* Kb, const bf16* Vb, float* LSE, int tid, int wid, int lane) {
    const int g = U >> 10, rem = U & 1023, b = rem >> 7, h = (rem >> 4) & 7, cq = rem & 15;
    const int sh = 2 * g, nbs = 4 - sh, c = cq >> nbs, qb = cq & ((1 << nbs) - 1);
    const int j0 = 256 * qb - 128, rowb = b * SEQ + c;
    const size_t colo = (size_t)g * 512 + h * 64;
    v4u kv[6], vv[6];
#pragma unroll
    for (int i = 0; i < 6; ++i) { const int idx = i * 512 + tid, key = idx >> 3, ch = idx & 7, j = j0 + key;
        kv[i] = (v4u){0u, 0u, 0u, 0u}; vv[i] = (v4u){0u, 0u, 0u, 0u};
        if (j >= 0) { const size_t off = (size_t)(rowb + (j << sh)) * 1536 + colo + ch * 8; kv[i] = *(const GAS v4u*)(Kb + off); vv[i] = *(const GAS v4u*)(Vb + off); } }
    const int r32 = lane & 31, hi = lane >> 5;
    const size_t qrow = (size_t)(rowb + ((256 * qb + 32 * wid + r32) << sh));
    bf16x8 qr[4];
#pragma unroll
    for (int d0 = 0; d0 < 4; ++d0) qr[d0] = *(const GAS bf16x8*)(Qb + qrow * 1536 + colo + hi * 8 + d0 * 16);
#pragma unroll
    for (int i = 0; i < 6; ++i) { const int idx = i * 512 + tid, key = idx >> 3, ch = idx & 7;
        *(LAS v4u*)(lds + LDS_KO + ch * KCH + key * 16) = kv[i];
        *(LAS v4u*)(lds + LDS_VO + ((key >> 3) * 2 + (ch >> 2)) * 512 + (key & 7) * 64 + (ch & 3) * 16) = vv[i]; }
    __syncthreads();
    f32x16 p[5];
#pragma unroll
    for (int kt = 0; kt < 5; ++kt) {
        const bool ex = (qb > 0) || (wid + kt >= 4);
        if (ex) { f32x16 a = {}; const LAS unsigned char* kp = lds + LDS_KO + hi * KCH + (32 * (wid + kt) + r32) * 16;
#pragma unroll
            for (int d0 = 0; d0 < 4; ++d0) a = __builtin_amdgcn_mfma_f32_32x32x16_bf16(*(const LAS bf16x8*)(kp + d0 * 2 * KCH), qr[d0], a, 0, 0, 0);
            p[kt] = a;
        } else {
#pragma unroll
            for (int r = 0; r < 16; ++r) p[kt][r] = -INFINITY; }
    }
#pragma unroll
    for (int r = 0; r < 16; ++r) { const int cr = (r & 3) + 8 * (r >> 2) + 4 * hi; if (cr < r32) p[0][r] = -INFINITY; if (cr > r32) p[4][r] = -INFINITY; }
    float m = -INFINITY;
#pragma unroll
    for (int kt = 0; kt < 5; ++kt)
#pragma unroll
        for (int r = 0; r < 16; ++r) m = fmaxf(m, p[kt][r]);
    m = fmaxf(m, __shfl_xor(m, 32));
    float l = 0.f;
#pragma unroll
    for (int kt = 0; kt < 5; ++kt)
#pragma unroll
        for (int r = 0; r < 16; ++r) { p[kt][r] = __builtin_amdgcn_exp2f(p[kt][r] - m); l += p[kt][r]; }
    l += __shfl_xor(l, 32);
    f32x16 o0 = {}, o1 = {};
    const int gi = lane >> 4, q_ = (lane & 15) >> 2, p_ = lane & 3;
    const LAS unsigned char* vbase = lds + LDS_VO + (4 * hi + q_) * 64 + (gi & 1) * 32 + p_ * 8;
#pragma unroll
    for (int kt = 0; kt < 5; ++kt) {
        const bool ex = (qb > 0) || (wid + kt >= 4);
        if (ex) {
#pragma unroll
            for (int s = 0; s < 2; ++s) {
                v4u pw; pw.x = cvtpk_s(p[kt][8 * s + 0], p[kt][8 * s + 1]); pw.y = cvtpk_s(p[kt][8 * s + 2], p[kt][8 * s + 3]); pw.z = cvtpk_s(p[kt][8 * s + 4], p[kt][8 * s + 5]); pw.w = cvtpk_s(p[kt][8 * s + 6], p[kt][8 * s + 7]);
                const bf16x8 pb = __builtin_bit_cast(bf16x8, pw);
                const LAS unsigned char* vp = vbase + (4 * (wid + kt) + 2 * s) * 1024;
                const s16x4 a00 = vtr(vp), a01 = vtr(vp + 1024), a10 = vtr(vp + 512), a11 = vtr(vp + 1536);
                const bf16x8 A0 = (bf16x8){a00[0], a00[1], a00[2], a00[3], a01[0], a01[1], a01[2], a01[3]}, A1 = (bf16x8){a10[0], a10[1], a10[2], a10[3], a11[0], a11[1], a11[2], a11[3]};
                o0 = __builtin_amdgcn_mfma_f32_32x32x16_bf16(A0, pb, o0, 0, 0, 0); o1 = __builtin_amdgcn_mfma_f32_32x32x16_bf16(A1, pb, o1, 0, 0, 0);
            }
        }
    }
    const float inv = 1.0f / l;
    bf16* op = Qb + qrow * 1536 + colo + 4 * hi;
#pragma unroll
    for (int rg = 0; rg < 4; ++rg) {
        u32x2 w0, w1; w0.x = cvtpk_s(o0[4 * rg] * inv, o0[4 * rg + 1] * inv); w0.y = cvtpk_s(o0[4 * rg + 2] * inv, o0[4 * rg + 3] * inv);
        w1.x = cvtpk_s(o1[4 * rg] * inv, o1[4 * rg + 1] * inv); w1.y = cvtpk_s(o1[4 * rg + 2] * inv, o1[4 * rg + 3] * inv);
        *(GAS u32x2*)(op + 8 * rg) = w0; *(GAS u32x2*)(op + 32 + 8 * rg) = w1; }
    if (hi == 0) LSE[((size_t)g * T + qrow) * 8 + h] = m + __builtin_amdgcn_logf(l);
    __syncthreads();
}
}

__device__ __forceinline__ void sg_unit(Frame& F, int unit) {
    LAS unsigned char* lds = F.lds; const int lane = F.lane, wid = F.wave, tid = F.tid;
    const int row0 = unit * 128;
    const bf16* UV = (const bf16*)(F.ws + WS_UV); bf16* AB = (bf16*)(F.ws + WS_AB); const bf16* OG = (const bf16*)(F.ws + WS_Q); const float* LSE = (const float*)(F.ws + WS_LSE);
    const bf16* wsg = (const bf16*)(F.ws + WS_WSG);
    {
        const f32x4 ga = *(const f32x4*)(F.in[3] + 8 * lane), gb = *(const f32x4*)(F.in[3] + 8 * lane + 4), ba = *(const f32x4*)(F.in[4] + 8 * lane), bb = *(const f32x4*)(F.in[4] + 8 * lane + 4);
        for (int tk = 0; tk < 16; ++tk) { const int s = wid * 16 + tk;
            const v4u raw = *(const GAS v4u*)(UV + (size_t)(row0 + s) * 1024 + 512 + 8 * lane);
            float x[8] = {bf_lo(raw.x), bf_hi(raw.x), bf_lo(raw.y), bf_hi(raw.y), bf_lo(raw.z), bf_hi(raw.z), bf_lo(raw.w), bf_hi(raw.w)};
            float sm = ((x[0] + x[1]) + (x[2] + x[3])) + ((x[4] + x[5]) + (x[6] + x[7]));
            const float mean = wave_sum(sm) * (1.0f / 512.0f); float sq = 0.f;
#pragma unroll
            for (int e = 0; e < 8; ++e) { x[e] -= mean; sq += x[e] * x[e]; }
            const float rstd = __builtin_amdgcn_rsqf(wave_sum(sq) * (1.0f / 512.0f) + 1e-6f);
            v4u o; o.x = cvtpk_s(x[0] * rstd * ga[0] + ba[0], x[1] * rstd * ga[1] + ba[1]); o.y = cvtpk_s(x[2] * rstd * ga[2] + ba[2], x[3] * rstd * ga[3] + ba[3]);
            o.z = cvtpk_s(x[4] * rstd * gb[0] + bb[0], x[5] * rstd * gb[1] + bb[1]); o.w = cvtpk_s(x[6] * rstd * gb[2] + bb[2], x[7] * rstd * gb[3] + bb[3]);
            *(LAS v4u*)(lds + ((s >> 3) * 16 + (lane >> 2)) * 512 + (s & 7) * 64 + (lane & 3) * 16) = o; }
    }
    __syncthreads();
    {
        const int r32 = lane & 31, hi = lane >> 5, gi = lane >> 4, q_ = (lane & 15) >> 2, p_ = lane & 3;
        const int g = wid >> 1, ch0 = g * 128 + (wid & 1) * 64;
        f32x16 acc[2][4];
#pragma unroll
        for (int ct = 0; ct < 2; ++ct)
#pragma unroll
            for (int tt = 0; tt < 4; ++tt) acc[ct][tt] = (f32x16){};
        const LAS unsigned char* abase = lds + (hi * 16 + (ch0 >> 5)) * 512 + q_ * 64 + (gi & 1) * 32 + p_ * 8;
        const bf16* wb = wsg + (size_t)(g * 128 + r32) * 128 + 8 * hi;
#pragma unroll
        for (int ks = 0; ks < 8; ++ks) {
            bf16x8 A[2];
#pragma unroll
            for (int ct = 0; ct < 2; ++ct) { const s16x4 lo = att::vtr(abase + (2 * ks * 16 + ct) * 512), hh = att::vtr(abase + (2 * ks * 16 + ct) * 512 + 256);
                A[ct] = (bf16x8){lo[0], lo[1], lo[2], lo[3], hh[0], hh[1], hh[2], hh[3]}; }
#pragma unroll
            for (int tt = 0; tt < 4; ++tt) if (ks < 2 * (tt + 1)) {
                const bf16x8 B = *(const GAS bf16x8*)(wb + (size_t)(32 * tt) * 128 + 16 * ks);
#pragma unroll
                for (int ct = 0; ct < 2; ++ct) acc[ct][tt] = __builtin_amdgcn_mfma_f32_32x32x16_bf16(A[ct], B, acc[ct][tt], 0, 0, 0); }
        }
        const float* bias = F.in[6] + g * 128;
#pragma unroll
        for (int tt = 0; tt < 4; ++tt) { const int t = 32 * tt + r32; const float bs = bias[t]; const size_t ro = (size_t)(row0 + t) * 1024;
#pragma unroll
            for (int ct = 0; ct < 2; ++ct)
#pragma unroll
                for (int rg = 0; rg < 4; ++rg) { const int c = ch0 + 32 * ct + 8 * rg + 4 * hi;
                    const u32x2 uu = *(const GAS u32x2*)(UV + ro + c);
                    u32x2 w; w.x = cvtpk_s(bf_lo(uu.x) * (acc[ct][tt][4 * rg] + bs), bf_hi(uu.x) * (acc[ct][tt][4 * rg + 1] + bs)); w.y = cvtpk_s(bf_lo(uu.y) * (acc[ct][tt][4 * rg + 2] + bs), bf_hi(uu.y) * (acc[ct][tt][4 * rg + 3] + bs));
                    *(GAS u32x2*)(AB + ro + c) = w; } }
    }
    for (int i = 0; i < 16; ++i) { const int idx = i * 512 + tid, tk = idx >> 6, pc = idx & 63, head = pc >> 3; const size_t row = (size_t)(row0 + tk);
        const float l0 = LSE[row * 8 + head], l1 = LSE[((size_t)T + row) * 8 + head], l2 = LSE[((size_t)2 * T + row) * 8 + head];
        const float mx = fmaxf(l0, fmaxf(l1, l2)); float w0 = __builtin_amdgcn_exp2f(l0 - mx), w1 = __builtin_amdgcn_exp2f(l1 - mx), w2 = __builtin_amdgcn_exp2f(l2 - mx);
        const float iv = 1.0f / (w0 + w1 + w2); w0 *= iv; w1 *= iv; w2 *= iv;
        const v4u a = *(const GAS v4u*)(OG + row * 1536 + pc * 8), b = *(const GAS v4u*)(OG + row * 1536 + 512 + pc * 8), c = *(const GAS v4u*)(OG + row * 1536 + 1024 + pc * 8);
        v4u o;
        o.x = cvtpk_s(w0 * bf_lo(a.x) + w1 * bf_lo(b.x) + w2 * bf_lo(c.x), w0 * bf_hi(a.x) + w1 * bf_hi(b.x) + w2 * bf_hi(c.x));
        o.y = cvtpk_s(w0 * bf_lo(a.y) + w1 * bf_lo(b.y) + w2 * bf_lo(c.y), w0 * bf_hi(a.y) + w1 * bf_hi(b.y) + w2 * bf_hi(c.y));
        o.z = cvtpk_s(w0 * bf_lo(a.z) + w1 * bf_lo(b.z) + w2 * bf_lo(c.z), w0 * bf_hi(a.z) + w1 * bf_hi(b.z) + w2 * bf_hi(c.z));
        o.w = cvtpk_s(w0 * bf_lo(a.w) + w1 * bf_lo(b.w) + w2 * bf_lo(c.w), w0 * bf_hi(a.w) + w1 * bf_hi(b.w) + w2 * bf_hi(c.w));
        *(GAS v4u*)(AB + row * 1024 + 512 + pc * 8) = o; }
    __syncthreads();
}

__device__ __forceinline__ void conv_unit(Frame& F, int unit) {
    LAS unsigned char* lds = F.lds; const int lane = F.lane, wid = F.wave, tid = F.tid;
    const int b = unit >> 6, t0 = (unit & 63) * 64; const size_t row0 = (size_t)b * SEQ + t0;
    const bf16* P1 = (const bf16*)(F.ws + WS_P1); bf16* CD = (bf16*)(F.ws + WS_CD);
    for (int idx = tid; idx < 94 * 64; idx += 512) { const int r = idx >> 6, pc = idx & 63, t = t0 - 30 + r; v4u v = (v4u){0u, 0u, 0u, 0u};
        if (t >= 0) v = *(const GAS v4u*)(P1 + ((size_t)b * SEQ + t) * 1536 + pc * 8);
        *(LAS v4u*)(lds + r * 1024 + pc * 16) = v; }
    const int ch = tid;
    float w[31];
#pragma unroll
    for (int j = 0; j < 31; ++j) w[j] = F.in[12][j * 512 + ch];
    const float cb = F.in[13][ch], lg = F.in[14][ch], lb = F.in[15][ch];
    const float wd0 = F.in[16][ch], wd1 = F.in[16][512 + ch], wd2 = F.in[16][1024 + ch];
    float xm2 = 0.f, xm1 = 0.f;
    if (t0 > 0) { xm2 = bf_lo((unsigned)P1[(row0 - 2) * 1536 + 1024 + ch]); xm1 = bf_lo((unsigned)P1[(row0 - 1) * 1536 + 1024 + ch]); }
    LAS float* part = (LAS float*)(lds + AUX_OFF);
    LAS float* fin = (LAS float*)(lds + AUX_OFF + 1024);
    __syncthreads();
    const LAS unsigned short* xs = (const LAS unsigned short*)(lds) + ch;
    for (int grp = 0; grp < 4; ++grp) {
        float cv[16];
#pragma unroll
        for (int o = 0; o < 16; ++o) cv[o] = cb;
        const LAS unsigned short* xg = xs + (size_t)(16 * grp) * 512;
#pragma unroll
        for (int i = 0; i < 46; ++i) { const float xv = bf_lo((unsigned)xg[i * 512]);
#pragma unroll
            for (int o = 0; o < 16; ++o) if (i - o >= 0 && i - o <= 30) cv[o] += w[i - o] * xv; }
#pragma unroll
        for (int o = 0; o < 16; ++o) { const float s1 = wave_sum(cv[o]), s2 = wave_sum(cv[o] * cv[o]); if (lane == 0) { part[(o * 8 + wid) * 2] = s1; part[(o * 8 + wid) * 2 + 1] = s2; } }
        __syncthreads();
        if (tid < 16) { float s1 = 0.f, s2 = 0.f;
#pragma unroll
            for (int k = 0; k < 8; ++k) { s1 += part[(tid * 8 + k) * 2]; s2 += part[(tid * 8 + k) * 2 + 1]; }
            const float mean = s1 * (1.0f / 512.0f), var = fmaxf(s2 * (1.0f / 512.0f) - mean * mean, 0.f);
            fin[tid * 2] = mean; fin[tid * 2 + 1] = __builtin_amdgcn_rsqf(var + 1e-6f); }
        __syncthreads();
#pragma unroll
        for (int o = 0; o < 16; ++o) { const size_t row = row0 + 16 * grp + o;
            const float mean = fin[o * 2], rstd = fin[o * 2 + 1];
            const float y = (cv[o] - mean) * rstd * lg + lb, sl = y * pg8::sigmoid_f(y);
            CD[row * 1024 + ch] = (bf16)f2bf(sl);
            const float xv = bf_lo((unsigned)P1[row * 1536 + 1024 + ch]), gbv = bf_lo((unsigned)P1[row * 1536 + 512 + ch]);
            CD[row * 1024 + 512 + ch] = (bf16)f2bf(gbv * (wd0 * xm2 + wd1 * xm1 + wd2 * xv));
            xm2 = xm1; xm1 = xv; }
    }
    __syncthreads();
}

constexpr int NPHASES = 12;
struct Args { const float* in[22]; float* out; unsigned char* ws; int ph_lo, ph_hi; };
__global__ void __launch_bounds__(NWAVES * 64, 2) mk_fwd(Args args) {
    extern __shared__ __attribute__((aligned(16))) unsigned char lds_raw[];
    Frame F;
    F.lds = (LAS unsigned char*)lds_raw;
    F.MISC = (volatile LAS unsigned*)(F.lds + MISC_OFF);
    F.tid = threadIdx.x; F.lane = F.tid & 63; F.wave = __builtin_amdgcn_readfirstlane(F.tid >> 6);
    F.G = gridDim.x; { const int bx = blockIdx.x; F.vcu = (F.G % 8 == 0) ? (bx % 8) * (F.G / 8) + bx / 8 : bx; }
    unsigned char* ws = args.ws; F.ws = ws; F.out = args.out;
#pragma unroll
    for (int i = 0; i < 22; ++i) F.in[i] = args.in[i];
    F.ctl = (gu32*)(ws + WS_CTL);
    for (int u = F.tid; u < 1024 / 4; u += NWAVES * 64) ((LAS unsigned*)(F.lds + LDSCTL_OFF))[u] = 0u;
    __syncthreads();
    const int lo = args.ph_lo, hi = args.ph_hi;
    XcdBarrier bar; bar.bar = (unsigned*)(F.ctl + CW_BAR); bar.x = 0; bar.st = nullptr;
    if (hi - lo > 1) bar = xcd_barrier_post((unsigned*)(F.ctl + CW_BAR), F.MISC + 8);
#define IN(k) (lo <= (k) && (k) < hi)
#define SEAM(k) do { if (IN(k) && IN((k) + 1)) xcd_barrier(bar); } while (0)
    float* rss = (float*)(ws + WS_RSS);
    bf16* XB = (bf16*)(ws + WS_XB);

    if (IN(0)) { p0_prologue(F); SEAM(0); }

    if (IN(1)) {
        pg8::Gemm g{XB, (const bf16*)(ws + WS_W0IN), T, AB_IN, DM}; pg8::StaticOrder S; S.init(T, AB_IN, F.G, (int)blockIdx.x);
        pg8::EpiIn0 E{rss, (bf16*)(ws + WS_UV), (bf16*)(ws + WS_Q), (bf16*)(ws + WS_K), (bf16*)(ws + WS_V), F.in[7], F.in[8], (const float*)(ws + WS_ROPE)};
        pg8::gemm_phase<pg8::EpiIn0, pg8::StaticOrder, true, true>(F.lds + RING_OFF, g, S, E);
        SEAM(1);
    }
    if (IN(2)) {
        for (int i = 0;; ++i) { const int U = i * F.G + F.vcu; if (U >= att::NUNITS) break;
            att::attn_unit(F.lds, U, (bf16*)(ws + WS_Q), (const bf16*)(ws + WS_K), (const bf16*)(ws + WS_V), (float*)(ws + WS_LSE), F.tid, F.wave, F.lane); }
        SEAM(2);
    }
    if (IN(3)) {
        for (int u = F.vcu; u < T / 128; u += F.G) sg_unit(F, u);
        SEAM(3);
    }
    if (IN(4)) {
        pg8::Gemm g{(const bf16*)(ws + WS_AB), (const bf16*)(ws + WS_W0OUT), T, DM, DM}; pg8::StaticOrder S; S.init(T, DM, F.G, (int)blockIdx.x);
        pg8::EpiRes E{F.in[0], F.out, XB, rss + T};
        pg8::gemm_phase<pg8::EpiRes, pg8::StaticOrder, true, true>(F.lds + RING_OFF, g, S, E);
        SEAM(4);
    }
    if (IN(5)) {
        pg8::Gemm g{XB, (const bf16*)(ws + WS_W0GU), T, GU_N, DM}; pg8::StaticOrder S; S.init(T, GU_N, F.G, (int)blockIdx.x);
        pg8::EpiGU E{rss + T, (bf16*)(ws + WS_ACT), DFF};
        pg8::gemm_phase<pg8::EpiGU, pg8::StaticOrder, true, true>(F.lds + RING_OFF, g, S, E);
        SEAM(5);
    }
    if (IN(6)) {
        pg8::Gemm g{(const bf16*)(ws + WS_ACT), (const bf16*)(ws + WS_W0D), T, DM, DFF}; pg8::StaticOrder S; S.init(T, DM, F.G, (int)blockIdx.x);
        pg8::EpiRes E{F.out, F.out, XB, rss + 2 * T};
        pg8::gemm_phase<pg8::EpiRes, pg8::StaticOrder, true, true>(F.lds + RING_OFF, g, S, E);
        SEAM(6);
    }
    if (IN(7)) {
        pg8::Gemm g{XB, (const bf16*)(ws + WS_W1IN), T, CD_IN, DM}; pg8::StaticOrder S; S.init(T, CD_IN, F.G, (int)blockIdx.x);
        pg8::EpiIn1 E{rss + 2 * T, (bf16*)(ws + WS_P1)};
        pg8::gemm_phase<pg8::EpiIn1, pg8::StaticOrder, true, true>(F.lds + RING_OFF, g, S, E);
        SEAM(7);
    }
    if (IN(8)) {
        for (int u = F.vcu; u < T / 64; u += F.G) conv_unit(F, u);
        SEAM(8);
    }
    if (IN(9)) {
        pg8::Gemm g{(const bf16*)(ws + WS_CD), (const bf16*)(ws + WS_W1OUT), T, DM, DM}; pg8::StaticOrder S; S.init(T, DM, F.G, (int)blockIdx.x);
        pg8::EpiRes E{F.out, F.out, XB, rss + 3 * T};
        pg8::gemm_phase<pg8::EpiRes, pg8::StaticOrder, true, true>(F.lds + RING_OFF, g, S, E);
        SEAM(9);
    }
    if (IN(10)) {
        pg8::Gemm g{XB, (const bf16*)(ws + WS_W1GU), T, GU_N, DM}; pg8::StaticOrder S; S.init(T, GU_N, F.G, (int)blockIdx.x);
        pg8::EpiGU E{rss + 3 * T, (bf16*)(ws + WS_ACT), DFF};
        pg8::gemm_phase<pg8::EpiGU, pg8::StaticOrder, true, true>(F.lds + RING_OFF, g, S, E);
        SEAM(10);
    }
    if (IN(11)) {
        pg8::Gemm g{(const bf16*)(ws + WS_ACT), (const bf16*)(ws + WS_W1D), T, DM, DFF}; pg8::StaticOrder S; S.init(T, DM, F.G, (int)blockIdx.x);
        pg8::EpiRes E{F.out, F.out, nullptr, nullptr};
        pg8::gemm_phase<pg8::EpiRes, pg8::StaticOrder, true, true>(F.lds + RING_OFF, g, S, E);
    }
#undef IN
#undef SEAM
}

#ifndef MK_PER_PHASE
#define MK_PER_PHASE 1
#endif
extern "C" void kernel_launch(void* const* d_in, const int* in_sizes, int n_in, void* d_out, int out_size, void* d_ws, size_t ws_size, hipStream_t stream) {
    static int grid = 0;
    if (grid == 0) {
        if (n_in != 22 || in_sizes[0] != T * DM || out_size != T * DM || ws_size < WS_END) { fprintf(stderr, "kernel_launch: unexpected shapes: n_in %d in0 %d out %d ws %zu (need %zu); nothing launched\n", n_in, n_in > 0 ? in_sizes[0] : -1, out_size, ws_size, (size_t)WS_END); grid = -1; return; }
        int dev = 0, cus = 0, per_cu = 0;
        if (hipGetDevice(&dev) != hipSuccess || hipDeviceGetAttribute(&cus, hipDeviceAttributeMultiprocessorCount, dev) != hipSuccess) { fprintf(stderr, "kernel_launch: device query failed\n"); grid = -1; return; }
        if (hipFuncSetAttribute((const void*)mk_fwd, hipFuncAttributeMaxDynamicSharedMemorySize, LDS_BYTES) != hipSuccess) { fprintf(stderr, "kernel_launch: hipFuncSetAttribute failed\n"); grid = -1; return; }
        if (hipOccupancyMaxActiveBlocksPerMultiprocessor(&per_cu, (const void*)mk_fwd, NWAVES * 64, LDS_BYTES) != hipSuccess || per_cu < 1) { fprintf(stderr, "kernel_launch: occupancy query says %d blocks per CU\n", per_cu); per_cu = 1; }
        (void)hipGetLastError();
        grid = cus;
        if (grid % 8 != 0 || grid > 256) grid = (grid / 8) * 8 > 256 ? 256 : (grid / 8) * 8;
    }
    if (grid <= 0) return;
    (void)hipMemsetAsync((char*)d_ws + WS_CTL, 0, CTL_ZERO_BYTES, stream);
    Args a{};
    for (int i = 0; i < 22; ++i) a.in[i] = (const float*)d_in[i];
    a.out = (float*)d_out; a.ws = (unsigned char*)d_ws;
#if MK_PER_PHASE
    for (int p = 0; p < NPHASES; ++p) { a.ph_lo = p; a.ph_hi = p + 1; hipLaunchKernelGGL(mk_fwd, dim3(grid), dim3(NWAVES * 64), LDS_BYTES, stream, a); }
#else
    a.ph_lo = 0; a.ph_hi = NPHASES;
    hipLaunchKernelGGL(mk_fwd, dim3(grid), dim3(NWAVES * 64), LDS_BYTES, stream, a);
#endif
    const hipError_t le = hipPeekAtLastError();
    if (le != hipSuccess) fprintf(stderr, "kernel_launch: launch failed: %s\n", hipGetErrorName(le));
}
```

```cpp
#include <hip/hip_runtime.h>
#include <cstdio>
#include <cstdint>
__device__ __forceinline__ int mk_lane_id() { return (int)__builtin_amdgcn_mbcnt_hi(~0u, __builtin_amdgcn_mbcnt_lo(~0u, 0u)); }
namespace pg8 {
#define PG8_LAS __attribute__((address_space(3)))
typedef unsigned short bf16_t;
typedef short bf16x8 __attribute__((ext_vector_type(8)));
typedef float f32x4 __attribute__((ext_vector_type(4)));
typedef unsigned u32x4 __attribute__((ext_vector_type(4)));
constexpr int BM = 256, BK = 64, HALF = 128, HTB = HALF * BK * 2  , STAGE_BYTES = 8 * HTB, NXCD = 8, WGM = 8;

__host__ __device__ __forceinline__ int lds_byte(int r, int c) { const int st = (r >> 4) * 2 + (c >> 5), rr = r & 15, cc = c & 31, ob = rr * 64 + cc * 2; return st * 1024 + (ob ^ (((ob >> 9) & 1) << 5)); }
__host__ __device__ __forceinline__ void stage_rc(int b, int& R, int& C) { const int st = b / 1024, sb = b % 1024, swz = sb ^ (((sb >> 9) & 1) << 5); R = (st >> 1) * 16 + swz / 64; C = (st & 1) * 32 + (swz % 64) / 2; }
__host__ __device__ __forceinline__ int perm32(int rho) { const int n = rho >> 4, i = rho & 15; return 8 * (i >> 2) + 4 * n + (i & 3); }

struct Unit { int pm, pn; };
struct Gemm { const bf16_t* A; const bf16_t* Bt; int M, N, K; };

struct StaticOrder {
    int nM, nN, nwg, G, c;
    __host__ __device__ void init(int M, int N, int G_, int c_) { nM = M / BM; nN = N / BM; nwg = nM * nN; G = G_; c = c_; }
    __host__ __device__ bool next(int i, Unit& u) const {
        const long L = (long)i * G + c; if (L >= nwg) return false;
        int wgid = (int)L; { const int q = nwg / NXCD, r = nwg % NXCD, xcd = wgid % NXCD, off = wgid / NXCD; wgid = (xcd < r ? xcd * (q + 1) : r * (q + 1) + (xcd - r) * q) + off; }
        const int nig = WGM * nN, gid = wgid / nig, fm = gid * WGM, gsz = (nM - fm) < WGM ? (nM - fm) : WGM;
        u.pm = fm + ((wgid % nig) % gsz); u.pn = (wgid % nig) / gsz; return true;
    }
    __device__ __forceinline__ void a_ready(const Unit&) const {}
    __device__ __forceinline__ void done(const Unit&) const {}
};

__device__ __forceinline__ unsigned cvt_pk_bf16(float lo, float hi) { unsigned r; asm volatile("v_cvt_pk_bf16_f32 %0, %1, %2" : "=v"(r) : "v"(lo), "v"(hi)); return r; }
typedef float f32x2 __attribute__((ext_vector_type(2)));
__device__ __forceinline__ f32x2 gelu_pk(f32x2 v) {
    const f32x2 av = __builtin_elementwise_abs(v), d = av * 0.2316418882f + 1.0f;
    f32x2 t; t.x = __builtin_amdgcn_rcpf(d.x); t.y = __builtin_amdgcn_rcpf(d.y);
    f32x2 q = t * 0.5307027145f + (-0.7265760135f); q = q * t + 0.7107068705f; q = q * t + (-0.142248368f); q = q * t + 0.127414796f; q = q * t;
    const f32x2 s = (v * v) * (-0.72134752044f);
    f32x2 e; e.x = __builtin_amdgcn_exp2f(s.x); e.y = __builtin_amdgcn_exp2f(s.y);
    const f32x2 m = v * (q * e), r = v - m;
    f32x2 o; o.x = v.x < 0.f ? m.x : r.x; o.y = v.y < 0.f ? m.y : r.y; return o;
}
template <class Epi, class Sched, bool ALIGN_EPI = false, bool SP2 = false>
__device__ __forceinline__ void gemm_phase(PG8_LAS unsigned char* lds, const Gemm g, const Sched& S, const Epi& E, const int wave_in) {
    int lane_ = mk_lane_id(); asm volatile("" : "+v"(lane_));
    const int lane = lane_, wid = wave_in, tid = wid * 64 + lane, wr = wid >> 2, wc = wid & 3, fr = lane & 15, fq = lane >> 4;
    const int K = g.K, nt = K / BK;
    unsigned voffA[2], voffB[2];
#pragma unroll
    for (int i = 0; i < 2; ++i) voffA[i] = voffB[i] = (unsigned)(tid * 16 + i * 8192);
    const size_t kstep = (size_t)(BM * BK * 2);
    const size_t hstep = (size_t)HALF * BK * 2;
    const size_t tstep = (size_t)(K / BK) * kstep;
    const unsigned ldsw = (unsigned)wid * 1024u;
    const int aoff = lds_byte(wr * 64 + fr, fq * 8), boff = lds_byte(wc * 32 + fr, fq * 8);
#define PG8_SA(b, h) (((b) * 2 + (h)) * HTB)
#define PG8_SB(b, h) ((4 + (b) * 2 + (h)) * HTB)
#define PG8_STAGE(bufoff, gbase, voff) do { _Pragma("unroll") for (int _i = 0; _i < 2; ++_i) \
        __builtin_amdgcn_global_load_lds((const unsigned*)((const char*)(gbase) + (voff)[_i]), (PG8_LAS unsigned*)(lds + (bufoff) + ldsw + _i * 8192), 16, 0, 0); } while (0)
#define PG8_LDA(dst, b, h) do { _Pragma("unroll") for (int m = 0; m < 4; ++m) _Pragma("unroll") for (int k = 0; k < 2; ++k) dst[m][k] = *(const PG8_LAS bf16x8*)(lds + PG8_SA(b, h) + aoff + m * 2048 + k * 1024); } while (0)
#define PG8_LDB(dst, b, h) do { _Pragma("unroll") for (int n = 0; n < 2; ++n) _Pragma("unroll") for (int k = 0; k < 2; ++k) dst[n][k] = *(const PG8_LAS bf16x8*)(lds + PG8_SB(b, h) + boff + n * 2048 + k * 1024); } while (0)
#define PG8_MMA(ai, bj, At, Bt) do { __builtin_amdgcn_s_setprio(1); _Pragma("unroll") for (int m = 0; m < 4; ++m) _Pragma("unroll") for (int n = 0; n < 2; ++n) _Pragma("unroll") for (int k = 0; k < 2; ++k) \
        acc[ai][bj][m][n] = __builtin_amdgcn_mfma_f32_16x16x32_bf16(Bt[n][k], At[m][k], acc[ai][bj][m][n], 0, 0, 0); __builtin_amdgcn_s_setprio(0); } while (0)
#define PG8_WAIT_V(n) asm volatile("s_waitcnt vmcnt(" #n ")" ::: "memory")
#define PG8_WAIT_L(n) asm volatile("s_waitcnt lgkmcnt(" #n ")" ::: "memory")
#define PG8_BAR __builtin_amdgcn_s_barrier()
#define PG8_SCHED __builtin_amdgcn_sched_barrier(0)
    Unit cur, nxt; int ui = 0;
    if (!S.next(0, cur)) return;
    f32x4 acc[2][2][4][2];
#pragma unroll
    for (int a = 0; a < 2; ++a)
#pragma unroll
        for (int b = 0; b < 2; ++b)
#pragma unroll
            for (int m = 0; m < 4; ++m)
#pragma unroll
                for (int n = 0; n < 2; ++n) acc[a][b][m][n] = (f32x4){0.f, 0.f, 0.f, 0.f};
    bf16x8 At[4][2], B0[2][2], B1[2][2];
    const char* cA = (const char*)g.A + (size_t)cur.pm * tstep; const char* cB = (const char*)g.Bt + (size_t)cur.pn * tstep;
    S.a_ready(cur);
    if constexpr (SP2) {
        PG8_STAGE(PG8_SB(0, 0), cB, voffB); PG8_STAGE(PG8_SB(0, 1), cB + hstep, voffB); PG8_STAGE(PG8_SA(0, 0), cA, voffA); PG8_STAGE(PG8_SA(0, 1), cA + hstep, voffA);
        if (wr == 1) PG8_BAR;
        PG8_WAIT_V(2); PG8_BAR;
        PG8_STAGE(PG8_SB(1, 0), cB + kstep, voffB); PG8_STAGE(PG8_SA(1, 0), cA + kstep, voffA); PG8_STAGE(PG8_SB(1, 1), cB + hstep + kstep, voffB);
        PG8_WAIT_V(6); PG8_BAR;
    } else {
        PG8_STAGE(PG8_SB(0, 0), cB, voffB); PG8_STAGE(PG8_SA(0, 0), cA, voffA); PG8_STAGE(PG8_SB(0, 1), cB + hstep, voffB); PG8_STAGE(PG8_SA(0, 1), cA + hstep, voffA);
        if (wr == 1) PG8_BAR;
        PG8_WAIT_V(4); PG8_BAR;
        PG8_STAGE(PG8_SB(1, 0), cB + kstep, voffB); PG8_STAGE(PG8_SA(1, 0), cA + kstep, voffA); PG8_STAGE(PG8_SB(1, 1), cB + hstep + kstep, voffB);
        PG8_WAIT_V(6); PG8_BAR;
    }
    for (;;) {
        const bool has_next = S.next(ui + 1, nxt);
        const char* nA = has_next ? (const char*)g.A + (size_t)nxt.pm * tstep : cA; const char* nB = has_next ? (const char*)g.Bt + (size_t)nxt.pn * tstep : cB;
        for (int t = 0; t < nt; t += 2) {
            const bool last = (t == nt - 2);
            const char* a1 = cA + (size_t)(t + 1) * kstep;
            const char* a2 = last ? nA : cA + (size_t)(t + 2) * kstep; const char* b2 = last ? nB : cB + (size_t)(t + 2) * kstep;
            const char* a3 = a2 + kstep; const char* b3 = b2 + kstep;
            if (last) E.prefetch(cur, wr, fq * 16 + fr);
            if (last && has_next) S.a_ready(nxt);
            if constexpr (SP2) {
            PG8_LDB(B0, 0, 0); PG8_LDB(B1, 0, 1); PG8_SCHED; PG8_LDA(At, 0, 0); PG8_STAGE(PG8_SA(1, 1), a1 + hstep, voffA);
            PG8_WAIT_V(8); PG8_WAIT_L(0); PG8_BAR; PG8_MMA(0, 0, At, B0); PG8_MMA(0, 1, At, B1); PG8_BAR; PG8_SCHED;
            PG8_LDA(At, 0, 1); PG8_STAGE(PG8_SB(0, 0), b2, voffB); PG8_STAGE(PG8_SB(0, 1), b2 + hstep, voffB); PG8_STAGE(PG8_SA(0, 0), a2, voffA);
            PG8_WAIT_V(8); PG8_WAIT_L(0); PG8_BAR; PG8_MMA(1, 0, At, B0); PG8_MMA(1, 1, At, B1); PG8_BAR; PG8_SCHED;
            PG8_LDB(B0, 1, 0); PG8_LDB(B1, 1, 1); PG8_SCHED; PG8_LDA(At, 1, 0); PG8_STAGE(PG8_SA(0, 1), a2 + hstep, voffA);
            PG8_WAIT_V(8); PG8_WAIT_L(0); PG8_BAR; PG8_MMA(0, 0, At, B0); PG8_MMA(0, 1, At, B1); PG8_BAR; PG8_SCHED;
            PG8_LDA(At, 1, 1); PG8_STAGE(PG8_SB(1, 0), b3, voffB); PG8_STAGE(PG8_SB(1, 1), b3 + hstep, voffB); PG8_STAGE(PG8_SA(1, 0), a3, voffA);
            PG8_WAIT_V(8); PG8_WAIT_L(0); PG8_BAR; PG8_MMA(1, 0, At, B0); PG8_MMA(1, 1, At, B1); PG8_BAR; PG8_SCHED;
            } else {
            PG8_LDB(B0, 0, 0); PG8_SCHED; PG8_LDA(At, 0, 0); PG8_STAGE(PG8_SA(1, 1), a1 + hstep, voffA);
            PG8_WAIT_L(8); PG8_BAR; PG8_WAIT_L(0); PG8_MMA(0, 0, At, B0); PG8_BAR; PG8_SCHED;
            PG8_LDB(B1, 0, 1); PG8_STAGE(PG8_SB(0, 0), b2, voffB);
            PG8_BAR; PG8_WAIT_L(0); PG8_MMA(0, 1, At, B1); PG8_BAR;
            PG8_LDA(At, 0, 1); PG8_STAGE(PG8_SA(0, 0), a2, voffA);
            PG8_BAR; PG8_WAIT_L(0); PG8_MMA(1, 0, At, B0); PG8_BAR; PG8_SCHED;
            PG8_STAGE(PG8_SB(0, 1), b2 + hstep, voffB);
            PG8_WAIT_V(6); PG8_BAR; PG8_MMA(1, 1, At, B1); PG8_BAR;
            PG8_LDB(B0, 1, 0); PG8_SCHED; PG8_LDA(At, 1, 0); PG8_STAGE(PG8_SA(0, 1), a2 + hstep, voffA);
            PG8_WAIT_L(8); PG8_BAR; PG8_WAIT_L(0); PG8_MMA(0, 0, At, B0); PG8_BAR; PG8_SCHED;
            PG8_LDB(B1, 1, 1); PG8_STAGE(PG8_SB(1, 0), b3, voffB);
            PG8_BAR; PG8_WAIT_L(0); PG8_MMA(0, 1, At, B1); PG8_BAR;
            PG8_LDA(At, 1, 1); PG8_STAGE(PG8_SA(1, 0), a3, voffA);
            PG8_BAR; PG8_WAIT_L(0); PG8_MMA(1, 0, At, B0); PG8_BAR; PG8_SCHED;
            PG8_STAGE(PG8_SB(1, 1), b3 + hstep, voffB);
            PG8_WAIT_V(6); PG8_BAR; PG8_MMA(1, 1, At, B1); PG8_BAR;
            }
        }
        if constexpr (ALIGN_EPI) { if (wr == 0) PG8_BAR; }
        if constexpr (!Epi::AFTER_DRAIN) { E(acc, cur, wr, wc, fr, fq); S.done(cur); }
        if (!has_next) break;
#pragma unroll
        for (int a = 0; a < 2; ++a)
#pragma unroll
            for (int b = 0; b < 2; ++b)
#pragma unroll
                for (int m = 0; m < 4; ++m)
#pragma unroll
                    for (int n = 0; n < 2; ++n) acc[a][b][m][n] = (f32x4){0.f, 0.f, 0.f, 0.f};
        cur = nxt; cA = nA; cB = nB; ++ui;
        if constexpr (ALIGN_EPI) { if (wr == 1) PG8_BAR; }
    }
    PG8_WAIT_V(0);
    if constexpr (!ALIGN_EPI) { if (wr == 0) PG8_BAR; }
    PG8_BAR;
    if constexpr (Epi::AFTER_DRAIN) { E.fused(acc, cur, wr, wc, fr, fq, lds, wid, lane); S.done(cur); }
#undef PG8_SA
#undef PG8_SB
#undef PG8_STAGE
#undef PG8_LDA
#undef PG8_LDB
#undef PG8_MMA
#undef PG8_WAIT_V
#undef PG8_WAIT_L
#undef PG8_BAR
#undef PG8_SCHED
}
}
namespace pg8 {
constexpr float NORM_EPS = 1e-6f;
typedef unsigned u32x2 __attribute__((ext_vector_type(2)));
__device__ __forceinline__ float sigmoid_f(float x) { return __builtin_amdgcn_rcpf(1.0f + __builtin_amdgcn_exp2f(-1.4426950408889634f * x)); }
__device__ __forceinline__ unsigned cvt2(float lo, float hi) { typedef float f2_t __attribute__((ext_vector_type(2))); typedef __bf16 b2_t __attribute__((ext_vector_type(2))); f2_t v = {lo, hi}; b2_t b = __builtin_convertvector(v, b2_t); return __builtin_bit_cast(unsigned, b); }
__device__ __forceinline__ u32x4 pack8(const f32x4 a, const f32x4 b) { u32x4 w; w.x = cvt2(a[0], a[1]); w.y = cvt2(a[2], a[3]); w.z = cvt2(b[0], b[1]); w.w = cvt2(b[2], b[3]); return w; }
__device__ __forceinline__ float dot4(const f32x4 a) { return (a[0] * a[0] + a[1] * a[1]) + (a[2] * a[2] + a[3] * a[3]); }

constexpr int XP_PITCH2 = 144, XP_PITCH1 = 80, XP_WAVE = 16 * XP_PITCH2;
__host__ __device__ __forceinline__ size_t kt_off(int row, int col, int ktiles) { return ((size_t)((row >> 8) * ktiles + (col >> 6)) * 256 + (row & 255)) * 64 + (col & 63); }
__host__ __device__ __forceinline__ size_t img_off(int row, int col, int ktiles) { return (((size_t)((row >> 8) * ktiles + (col >> 6)) * 2 + ((row >> 7) & 1)) * 16384 + lds_byte(row & 127, col & 63)) >> 1; }
__host__ __device__ __forceinline__ int invperm32(int j) { return 16 * ((j >> 2) & 1) + 4 * (j >> 3) + (j & 3); }
__host__ __device__ __forceinline__ size_t hm_off(int g, int b, int h, int t) { const int sh = 2 * g; return ((size_t)((((g * 8 + b) * 8 + h) << 12) + ((t & ((1 << sh) - 1)) << (12 - sh)) + (t >> sh))) * 64; }
__device__ __forceinline__ void xp_store2(PG8_LAS unsigned char* xs, int fr, int fq, const u32x4 w0, const u32x4 w1, bf16_t* base, int ld) {
    const int lane = fq * 16 + fr;
    *(PG8_LAS u32x4*)(xs + fr * XP_PITCH2 + fq * 16) = w0; *(PG8_LAS u32x4*)(xs + fr * XP_PITCH2 + 64 + fq * 16) = w1;
    const u32x4 a = *(const PG8_LAS u32x4*)(xs + (lane >> 3) * XP_PITCH2 + (lane & 7) * 16), b = *(const PG8_LAS u32x4*)(xs + ((lane >> 3) + 8) * XP_PITCH2 + (lane & 7) * 16);
    __builtin_nontemporal_store(a, (u32x4*)(base + (size_t)(lane >> 3) * ld + (lane & 7) * 8)); __builtin_nontemporal_store(b, (u32x4*)(base + (size_t)((lane >> 3) + 8) * ld + (lane & 7) * 8));
}
__device__ __forceinline__ void xp_put2(PG8_LAS unsigned char* xs, int fr, int fq, const u32x4 w0, const u32x4 w1, u32x4& a, u32x4& b) {
    const int lane = fq * 16 + fr;
    *(PG8_LAS u32x4*)(xs + fr * XP_PITCH2 + fq * 16) = w0; *(PG8_LAS u32x4*)(xs + fr * XP_PITCH2 + 64 + fq * 16) = w1;
    a = *(const PG8_LAS u32x4*)(xs + (lane >> 3) * XP_PITCH2 + (lane & 7) * 16); b = *(const PG8_LAS u32x4*)(xs + ((lane >> 3) + 8) * XP_PITCH2 + (lane & 7) * 16);
}
__device__ __forceinline__ void xp_put1(PG8_LAS unsigned char* xs, int fr, int fq, const u32x4 w0, u32x4& a) {
    const int lane = fq * 16 + fr;
    *(PG8_LAS u32x4*)(xs + fr * XP_PITCH1 + fq * 16) = w0;
    a = *(const PG8_LAS u32x4*)(xs + (lane >> 2) * XP_PITCH1 + (lane & 3) * 16);
}
__device__ __forceinline__ void nt16(const u32x4 v, bf16_t* p) { __builtin_nontemporal_store(v, (u32x4*)p); }
__device__ __forceinline__ f32x4 bf4_lo(unsigned a, unsigned b) { return (f32x4){__builtin_bit_cast(float, a << 16), __builtin_bit_cast(float, a & 0xffff0000u), __builtin_bit_cast(float, b << 16), __builtin_bit_cast(float, b & 0xffff0000u)}; }
struct EpiRes {
    static constexpr bool PERM = true, AFTER_DRAIN = false;
    __device__ __forceinline__ void prefetch(const Unit&, int, int) const {}
    bf16_t* xb; float* outf; float* rowss; PG8_LAS unsigned char* xs;
    __device__ __forceinline__ void operator()(const f32x4 (&acc)[2][2][4][2], const Unit& u, int wr, int wc, int fr, int fq) const {
        const int lane = fq * 16 + fr, rowg = u.pm * BM + wr * 64, colw = u.pn * BM + wc * 64;
        const int ob = fr * 64 + fq * 16, sw = ob ^ (((ob >> 9) & 1) << 5);
        bf16_t* const xw = xb + img_off(rowg, colw, 16) + (sw >> 1);
        u32x4 ga[8], gb[8];
#pragma unroll
        for (int i = 0; i < 8; ++i) { const bf16_t* g0 = xw + (i >> 2) * 8192 + (i & 3) * 1024; ga[i] = *(const u32x4*)g0; gb[i] = *(const u32x4*)(g0 + 512); }
#pragma unroll
        for (int ai = 0; ai < 2; ++ai)
#pragma unroll
            for (int m = 0; m < 4; ++m) {
                const int i = ai * 4 + m, row = rowg + ai * HALF + m * 16; const u32x4 r0 = ga[i], r1 = gb[i];
                const f32x4 v00 = acc[ai][0][m][0] + bf4_lo(r0.x, r0.y), v01 = acc[ai][0][m][1] + bf4_lo(r0.z, r0.w), v10 = acc[ai][1][m][0] + bf4_lo(r1.x, r1.y), v11 = acc[ai][1][m][1] + bf4_lo(r1.z, r1.w);
                if (outf) { float* o = outf + (size_t)row * 1024 + colw;
#pragma unroll
                    for (int bj = 0; bj < 2; ++bj) { const f32x4 x0 = bj ? v10 : v00, x1 = bj ? v11 : v01;
                        *(PG8_LAS f32x4*)(xs + fr * XP_PITCH2 + fq * 32) = x0; *(PG8_LAS f32x4*)(xs + fr * XP_PITCH2 + fq * 32 + 16) = x1;
                        const f32x4 a = *(const PG8_LAS f32x4*)(xs + (lane >> 3) * XP_PITCH2 + (lane & 7) * 16), b = *(const PG8_LAS f32x4*)(xs + ((lane >> 3) + 8) * XP_PITCH2 + (lane & 7) * 16);
                        __builtin_nontemporal_store(a, (f32x4*)(o + (size_t)(lane >> 3) * 1024 + bj * 32 + (lane & 7) * 4)); __builtin_nontemporal_store(b, (f32x4*)(o + (size_t)((lane >> 3) + 8) * 1024 + bj * 32 + (lane & 7) * 4)); } }
                else { bf16_t* g0 = xw + ai * 8192 + m * 1024; nt16(pack8(v00, v01), g0); nt16(pack8(v10, v11), g0 + 512); }
                if (rowss) { float ss = (dot4(v00) + dot4(v01)) + (dot4(v10) + dot4(v11)); ss += __shfl_xor(ss, 16); ss += __shfl_xor(ss, 32); if (fq == 0) atomicAdd(rowss + row + fr, ss); }
            }
    }
};

__device__ __forceinline__ void rs_prefetch(const float* rowss, int rowblk, int lane, PG8_LAS unsigned char* xs) {
    const float* src = rowss + rowblk + lane;
    __builtin_amdgcn_global_load_lds((const unsigned*)src, (PG8_LAS unsigned*)xs, 4, 0, 0);
    __builtin_amdgcn_global_load_lds((const unsigned*)(src + HALF), (PG8_LAS unsigned*)(xs + 256), 4, 0, 0);
}
__device__ __forceinline__ float rs_raw(const PG8_LAS unsigned char* xs, int i, int fr) { return ((const PG8_LAS float*)xs)[(i >> 2) * 64 + (i & 3) * 16 + fr]; }
__device__ __forceinline__ void load_rstd(float (&rs)[8], const float* rowss, int row0) {
#pragma unroll
    for (int i = 0; i < 8; ++i) rs[i] = rowss[row0 + (i >> 2) * HALF + (i & 3) * 16];
#pragma unroll
    for (int i = 0; i < 8; ++i) rs[i] = __builtin_amdgcn_rsqf(rs[i] * (1.0f / 1024.0f) + NORM_EPS);
}

__device__ __forceinline__ int dw_perm256(int n) { const int o = n & 255; return (n & ~255) + ((o >> 5) & 1) * 128 + (o >> 6) * 32 + (o & 31); }
__device__ __forceinline__ int dw_drow(int kind, int n) {
    if (kind == 2) return 256 * (n >> 7) + (n & 127);
    if (kind == 3) { if (n < 512) return 256 * (n >> 7) + (n & 127);
        if (n < 1024) { const int n1 = n - 512; return 256 * (n1 >> 7) + 128 + (n1 & 127); }
        if (n < 1536) return dw_perm256(n);
        if (n < 2048) { const int n1 = n - 1536; return 1536 + 256 * (n1 >> 7) + (n1 & 127); }
        const int n1 = n - 2048; return 1536 + 256 * (n1 >> 7) + 128 + (n1 & 127); }
    return dw_perm256(n);
}
constexpr int DW_NMAT = 6, DW_HALF_ITEMS = 2 * (1408 + 1280 + 512 + 1408 + 1408 + 1408);
struct DwTab { const float* W; const float* gain; bf16_t* WT; const void* pad; };
struct DwItem { const float* src; const float* gain; bf16_t* WT; int K, N, kind, radd, k0, n0; };
typedef unsigned u32x8s __attribute__((ext_vector_type(8)));
__device__ __forceinline__ void dw_desc(const DwTab* t, const float*& W, const float*& gain, bf16_t*& WT) {
    const unsigned long long a = (unsigned long long)t; const unsigned lo = __builtin_amdgcn_readfirstlane((unsigned)a), hi = __builtin_amdgcn_readfirstlane((unsigned)(a >> 32));
    const unsigned long long au = ((unsigned long long)hi << 32) | lo; u32x8s r;
    asm volatile("s_load_dwordx8 %0, %1, 0x0\n\ts_waitcnt lgkmcnt(0)" : "=s"(r) : "s"(au) : "memory");
    W = (const float*)(((unsigned long long)r[1] << 32) | r[0]); gain = (const float*)(((unsigned long long)r[3] << 32) | r[2]); WT = (bf16_t*)(((unsigned long long)r[5] << 32) | r[4]);
}
__device__ __forceinline__ DwItem dw_decode(const DwTab* tab, int did) {
    const int h = did & 1; int r = did >> 1, m;
    if (r < 1408) m = 0; else if ((r -= 1408) < 1280) m = 1; else if ((r -= 1280) < 512) m = 2; else if ((r -= 512) < 1408) m = 3; else if ((r -= 1408) < 1408) m = 4; else { r -= 1408; m = 5; }
    DwItem it; it.K = (m == 0 || m == 5) ? 2816 : 1024; it.N = m == 1 ? 2560 : ((m == 3 || m == 4) ? 2816 : 1024); it.kind = m == 1 ? 3 : ((m == 3 || m == 4) ? 2 : 0); it.radd = m == 4 ? 128 : 0;
    int kb, nb;
    if (m == 1) { kb = r / 40; nb = r - 40 * kb; } else if (m == 3 || m == 4) { kb = r / 44; nb = r - 44 * kb; } else { kb = r >> 4; nb = r & 15; }
    it.k0 = 32 * kb + 16 * h; it.n0 = 64 * nb; dw_desc(tab + m, it.src, it.gain, it.WT); return it;
}
constexpr int DW1_HALF_ITEMS = 2 * (512 + 1408 + 1408);
__device__ __forceinline__ DwItem dw_decode1(const DwTab* tab, int did) {
    const int h = did & 1; int r = did >> 1, m;
    if (r < 512) m = 0; else if ((r -= 512) < 1408) m = 1; else { r -= 1408; m = 2; }
    DwItem it; it.K = 1024; it.N = m == 0 ? 1024 : 2816; it.kind = m == 0 ? 0 : 2; it.radd = m == 2 ? 128 : 0;
    int kb, nb;
    if (m == 0) { kb = r >> 4; nb = r & 15; } else { kb = r / 44; nb = r - 44 * kb; }
    it.k0 = 32 * kb + 16 * h; it.n0 = 64 * nb; dw_desc(tab + 6 + m, it.src, it.gain, it.WT); return it;
}
__device__ __forceinline__ void dw_load(const DwItem& it, int lane, f32x4 (&wv)[4], float (&wg)[4]) {
    const int n4 = (lane & 15) * 4, kr = lane >> 4;
#pragma unroll
    for (int i = 0; i < 4; ++i) { const int k = it.k0 + 4 * kr + i; wv[i] = __builtin_nontemporal_load((const __attribute__((address_space(1))) f32x4*)(it.src + (size_t)k * it.N + it.n0 + n4)); wg[i] = ((const __attribute__((address_space(1))) float*)it.gain)[k]; }
}
__device__ __forceinline__ void dw_finish(const DwItem& it, int lane, const f32x4 (&wv)[4], const float (&wg)[4], PG8_LAS unsigned char* scr, bool on) {
    const int n4 = (lane & 15) * 4, kr = lane >> 4;
    const f32x4 x0 = wv[0] * wg[0], x1 = wv[1] * wg[1], x2 = wv[2] * wg[2], x3 = wv[3] * wg[3];
#pragma unroll
    for (int c = 0; c < 4; ++c) { u32x2 w; w.x = cvt2(x0[c], x1[c]); w.y = cvt2(x2[c], x3[c]); *(PG8_LAS u32x2*)(scr + (n4 + c) * 32 + kr * 8) = w; }
    asm volatile("" ::: "memory");
    const int kc = lane & 1, nr = lane >> 1;
#pragma unroll
    for (int j = 0; j < 2; ++j) { const int n = nr + 32 * j; const u32x4 o = *(const PG8_LAS u32x4*)(scr + n * 32 + kc * 16);
        const int nd = dw_drow(it.kind, it.n0 + n) + it.radd;
        if (on) *(__attribute__((address_space(1))) u32x4*)(it.WT + img_off((nd & ~31) + invperm32(nd & 31), it.k0 + 8 * kc, it.K >> 6)) = o; }
    asm volatile("" ::: "memory");
}

template <bool DW> struct EpiGUT {
    static constexpr bool PERM = true, AFTER_DRAIN = false;
    __device__ __forceinline__ void prefetch(const Unit& u, int wr, int lane) const { rs_prefetch(rowss, u.pm * BM + wr * 64, lane, xs); }
    const float* rowss; bf16_t* act; int ldc; PG8_LAS unsigned char* xs; const DwTab* dwtab;
    __device__ __forceinline__ void operator()(const f32x4 (&acc)[2][2][4][2], const Unit& u, int wr, int wc, int fr, int fq) const {
        const int lane = fq * 16 + fr, rowg = u.pm * BM + wr * 64, colw = u.pn * HALF + wc * 32;
        const int did = (u.pm * 22 + u.pn) * 8 + wr * 4 + wc; const bool dw = DW && did < DW_HALF_ITEMS;
        DwItem dit; f32x4 wv[4]; float wg[4];
        if constexpr (DW) { dit = dw_decode(dwtab, dw ? did : 0); dw_load(dit, lane, wv, wg); }
        asm volatile("" ::: "memory");
        float msv[8], rsv[8];
#pragma unroll
        for (int i = 0; i < 8; ++i) msv[i] = rs_raw(xs, i, fr) * (1.0f / 1024.0f) + NORM_EPS;
#pragma unroll
        for (int i = 0; i < 8; ++i) rsv[i] = __builtin_amdgcn_rsqf(msv[i]);
        const int ob = fr * 64 + fq * 16, sw = ob ^ (((ob >> 9) & 1) << 5);
        bf16_t* const tile = act + img_off(rowg, colw, ldc >> 6) + (sw >> 1);
#pragma unroll
        for (int ai = 0; ai < 2; ++ai)
#pragma unroll
            for (int m = 0; m < 4; ++m) {
                const int i = ai * 4 + m; const float rs = rsv[i];
                f32x4 o[2]; const float kq = -1.4426950408889634f * rs; const f32x2 ms = {msv[i], msv[i]};
#pragma unroll
                for (int n = 0; n < 2; ++n) { const f32x4 g4 = acc[ai][0][m][n], u4 = acc[ai][1][m][n];
#pragma unroll
                    for (int h = 0; h < 2; ++h) { const f32x2 g = {g4[2 * h], g4[2 * h + 1]}, u = {u4[2 * h], u4[2 * h + 1]};
                        const f32x2 p = g * u, t = g * kq; f32x2 e; e.x = __builtin_amdgcn_exp2f(t.x); e.y = __builtin_amdgcn_exp2f(t.y);
                        const f32x2 d = __builtin_elementwise_fma(e, ms, ms); f32x2 r; r.x = __builtin_amdgcn_rcpf(d.x); r.y = __builtin_amdgcn_rcpf(d.y);
                        const f32x2 q = p * r; o[n][2 * h] = q.x; o[n][2 * h + 1] = q.y; } }
                nt16(pack8(o[0], o[1]), tile + ai * 8192 + m * 1024);
            }
        if constexpr (DW) dw_finish(dit, lane, wv, wg, xs, dw);
    }
};

__device__ __forceinline__ float xchg16(float x) { const unsigned xb = __builtin_bit_cast(unsigned, x); const auto r = __builtin_amdgcn_permlane16_swap(xb, xb, false, false); const unsigned r0 = r[0], r1 = r[1];
    return __builtin_bit_cast(float, r0 ^ r1 ^ xb); }
__device__ __forceinline__ float sum16(float x) { const unsigned xb = __builtin_bit_cast(unsigned, x); const auto r = __builtin_amdgcn_permlane16_swap(xb, xb, false, false); const unsigned r0 = r[0], r1 = r[1];
    return __builtin_bit_cast(float, r0) + __builtin_bit_cast(float, r1); }
__device__ __forceinline__ float sum32(float x) { const unsigned xb = __builtin_bit_cast(unsigned, x); const auto r = __builtin_amdgcn_permlane32_swap(xb, xb, false, false); const unsigned r0 = r[0], r1 = r[1];
    return __builtin_bit_cast(float, r0) + __builtin_bit_cast(float, r1); }
struct EpiIn0 {
    static constexpr bool PERM = true, AFTER_DRAIN = false;
    __device__ __forceinline__ void prefetch(const Unit& u, int wr, int lane) const { rs_prefetch(rowss, u.pm * BM + wr * 64, lane, xs); }
    const float* rowss; bf16_t* UV; bf16_t* Qb; bf16_t* Kb; bf16_t* Vb; const float* qg; const float* kg; const float* rope; PG8_LAS unsigned char* xs; const DwTab* dwtab;
    __device__ __forceinline__ void operator()(const f32x4 (&acc)[2][2][4][2], const Unit& u, int wr, int wc, int fr_, int fq_) const {
        int lane = fq_ * 16 + fr_; asm volatile("" : "+v"(lane)); const int fr = lane & 15, fq = lane >> 4;
        const int rowg = u.pm * BM + wr * 64, row0 = rowg + fr, pn = u.pn;
        float rsv[8];
#pragma unroll
        for (int i = 0; i < 8; ++i) rsv[i] = __builtin_amdgcn_rsqf(rs_raw(xs, i, fr) * (1.0f / 1024.0f) + NORM_EPS);
        asm volatile("" ::: "memory");
        u32x4 pa, pb;
        if (pn >= 4 && pn < 16) {
            const int t = pn - 4, isk = t >= 6 ? 1 : 0, tt = t - 6 * isk, g = tt >> 1, head = 4 * (tt & 1) + wc;
            const int Ra = rowg + (lane >> 3), Rb = Ra + 8, sh = 2 * g;
            bf16_t* const pA = (isk ? Kb : Qb) + hm_off(g, Ra >> 12, head, Ra & 4095) + (lane & 7) * 8; bf16_t* const pB = (isk ? Kb : Qb) + hm_off(g, Rb >> 12, head, Rb & 4095) + (lane & 7) * 8;
            const float osc = isk ? 1.0f : 0.125f * 1.4426950408889634f;
            const float* gp = (isk ? kg : qg) + g * 64 + 8 * fq;
            const f32x4 g00 = *(const f32x4*)(gp) * osc, g01 = *(const f32x4*)(gp + 4) * osc, g10 = *(const f32x4*)(gp + 32) * osc, g11 = *(const f32x4*)(gp + 36) * osc;
            u32x4 rq[4][2];
            const unsigned flip = fq == 0 ? 0x80000000u : 0u;
#pragma unroll
            for (int i = 0; i < 4; ++i) { const int rown = row0 + i * 16; const unsigned* rp = (const unsigned*)rope + (size_t)(fq < 2 ? (rown & 4095) : 4096) * 8; rq[i][0] = *(const u32x4*)(rp); rq[i][1] = *(const u32x4*)(rp + 4); }
            float scv[8]; u32x4 oa[8], ob[8];
#pragma unroll
            for (int i = 0; i < 8; ++i) { const f32x4 a0 = acc[i >> 2][0][i & 3][0], a1 = acc[i >> 2][0][i & 3][1], b0 = acc[i >> 2][1][i & 3][0], b1 = acc[i >> 2][1][i & 3][1];
                f32x2 p = (f32x2){a0[0], a0[1]} * (f32x2){a0[0], a0[1]};
                p = __builtin_elementwise_fma((f32x2){a0[2], a0[3]}, (f32x2){a0[2], a0[3]}, p); p = __builtin_elementwise_fma((f32x2){a1[0], a1[1]}, (f32x2){a1[0], a1[1]}, p); p = __builtin_elementwise_fma((f32x2){a1[2], a1[3]}, (f32x2){a1[2], a1[3]}, p);
                p = __builtin_elementwise_fma((f32x2){b0[0], b0[1]}, (f32x2){b0[0], b0[1]}, p); p = __builtin_elementwise_fma((f32x2){b0[2], b0[3]}, (f32x2){b0[2], b0[3]}, p);
                p = __builtin_elementwise_fma((f32x2){b1[0], b1[1]}, (f32x2){b1[0], b1[1]}, p); p = __builtin_elementwise_fma((f32x2){b1[2], b1[3]}, (f32x2){b1[2], b1[3]}, p);
                scv[i] = p.x + p.y; }
#pragma unroll
            for (int i = 0; i < 8; ++i) scv[i] = sum32(sum16(scv[i]));
#pragma unroll
            for (int i = 0; i < 8; ++i) scv[i] = rsv[i] * __builtin_amdgcn_rsqf(scv[i] * (rsv[i] * rsv[i]) * (1.0f / 64.0f) + NORM_EPS);
#pragma unroll
            for (int ai = 0; ai < 2; ++ai)
#pragma unroll
                for (int m = 0; m < 4; ++m) {
                    const int i = ai * 4 + m;
                    f32x4 a0 = acc[ai][0][m][0], a1 = acc[ai][0][m][1], b0 = acc[ai][1][m][0], b1 = acc[ai][1][m][1];
                    const float sc = scv[i];
                    a0 = a0 * sc * g00; a1 = a1 * sc * g01; b0 = b0 * sc * g10; b1 = b1 * sc * g11;
                    const u32x4 r0 = rq[i & 3][0], r1 = rq[i & 3][1];
                    const unsigned rw[8] = {r0.x, r0.y, r0.z, r0.w, r1.x, r1.y, r1.z, r1.w};
                    const float mine[8] = {a0[0], a0[1], a0[2], a0[3], a1[0], a1[1], a1[2], a1[3]}; f32x2 rot[4];
#pragma unroll
                    for (int e = 0; e < 8; e += 2) { const f32x2 cs = {__builtin_bit_cast(float, rw[e] << 16), __builtin_bit_cast(float, rw[e + 1] << 16)};
                        const f32x2 sn = {__builtin_bit_cast(float, (rw[e] & 0xffff0000u) ^ flip), __builtin_bit_cast(float, (rw[e + 1] & 0xffff0000u) ^ flip)};
                        const f32x2 oth = {xchg16(mine[e]), xchg16(mine[e + 1])}, me = {mine[e], mine[e + 1]};
                        rot[e >> 1] = __builtin_elementwise_fma(oth, sn, me * cs); }
                    a0 = (f32x4){rot[0].x, rot[0].y, rot[1].x, rot[1].y}; a1 = (f32x4){rot[2].x, rot[2].y, rot[3].x, rot[3].y};
                    if (i < 4) { const int rown = row0 + HALF + i * 16; const unsigned* rp = (const unsigned*)rope + (size_t)(fq < 2 ? (rown & 4095) : 4096) * 8; rq[i][0] = *(const u32x4*)(rp); rq[i][1] = *(const u32x4*)(rp + 4); }
                    if (i >= 4 && i < 7) {
#pragma unroll
                        for (int j = 2 * (i - 4); j < 2 * (i - 4) + 2; ++j) { const size_t go = (size_t)((((j >> 2) * HALF + (j & 3) * 16) >> sh) * 64); nt16(oa[j], pA + go); nt16(ob[j], pB + go); } }
                    if (i == 7) { const size_t go = (size_t)(((HALF + 2 * 16) >> sh) * 64); nt16(oa[6], pA + go); nt16(ob[6], pB + go); }
                    xp_put2(xs, fr, fq, pack8(a0, a1), pack8(b0, b1), oa[i], ob[i]);
                }
            { const size_t go = (size_t)(((HALF + 3 * 16) >> sh) * 64); nt16(oa[7], pA + go); nt16(ob[7], pB + go); }
            return;
        }
        const int did = (u.pm * 10 + (pn < 4 ? pn : pn - 12)) * 8 + wr * 4 + wc; const bool dw = did < DW1_HALF_ITEMS;
        DwItem dit = dw_decode1(dwtab, dw ? did : 0); f32x4 wv[4]; float wg[4]; dw_load(dit, lane, wv, wg);
        asm volatile("" ::: "memory");
        if (pn < 4) {
            bf16_t* const tile = UV + kt_off(rowg, pn * BM + wc * 64, 16) + (size_t)(lane >> 3) * 64 + (lane & 7) * 8;
#pragma unroll
            for (int ai = 0; ai < 2; ++ai)
#pragma unroll
                for (int m = 0; m < 4; ++m) {
                    const int i = ai * 4 + m; const float rs = rsv[i]; u32x4 w[2];
#pragma unroll
                    for (int bj = 0; bj < 2; ++bj) { f32x4 v0 = acc[ai][bj][m][0] * rs, v1 = acc[ai][bj][m][1] * rs;
                        const f32x2 a = gelu_pk((f32x2){v0[0], v0[1]}), b = gelu_pk((f32x2){v0[2], v0[3]}), c = gelu_pk((f32x2){v1[0], v1[1]}), d = gelu_pk((f32x2){v1[2], v1[3]});
                        v0 = (f32x4){a.x, a.y, b.x, b.y}; v1 = (f32x4){c.x, c.y, d.x, d.y}; w[bj] = pack8(v0, v1); }
                    if (i > 0) { bf16_t* t0 = tile + (size_t)(((i - 1) >> 2) * HALF + ((i - 1) & 3) * 16) * 64; nt16(pa, t0); nt16(pb, t0 + 8 * 64); }
                    xp_put2(xs, fr, fq, w[0], w[1], pa, pb);
                }
            { bf16_t* t0 = tile + (size_t)(HALF + 3 * 16) * 64; nt16(pa, t0); nt16(pb, t0 + 8 * 64); }
        } else {
            const int g = (pn - 16) >> 1, head = 4 * ((pn - 16) & 1) + wc;
            const int Ra = rowg + (lane >> 3), Rb = Ra + 8, sh = 2 * g;
            bf16_t* const pA = Vb + hm_off(g, Ra >> 12, head, Ra & 4095) + (lane & 7) * 8; bf16_t* const pB = Vb + hm_off(g, Rb >> 12, head, Rb & 4095) + (lane & 7) * 8;
#pragma unroll
            for (int ai = 0; ai < 2; ++ai)
#pragma unroll
                for (int m = 0; m < 4; ++m) {
                    const int i = ai * 4 + m; const float rs = rsv[i];
                    if (i > 0) { const size_t go = (size_t)(((((i - 1) >> 2) * HALF + ((i - 1) & 3) * 16) >> sh) * 64); nt16(pa, pA + go); nt16(pb, pB + go); }
                    xp_put2(xs, fr, fq, pack8(acc[ai][0][m][0] * rs, acc[ai][0][m][1] * rs), pack8(acc[ai][1][m][0] * rs, acc[ai][1][m][1] * rs), pa, pb);
                }
            { const size_t go = (size_t)(((HALF + 3 * 16) >> sh) * 64); nt16(pa, pA + go); nt16(pb, pB + go); }
        }
        dw_finish(dit, lane, wv, wg, xs, dw);
    }
};

struct EpiIn1 {
    static constexpr bool PERM = true, AFTER_DRAIN = false;
    __device__ __forceinline__ void prefetch(const Unit& u, int wr, int lane) const { rs_prefetch(rowss, u.pm * BM + wr * 64, lane, xs); }
    const float* rowss; bf16_t* P1; PG8_LAS unsigned char* xs;
    __device__ __forceinline__ void operator()(const f32x4 (&acc)[2][2][4][2], const Unit& u, int wr, int wc, int fr, int fq) const {
        const int lane = fq * 16 + fr, rowg = u.pm * BM + wr * 64, pn = u.pn;
        float rsv[8];
#pragma unroll
        for (int i = 0; i < 8; ++i) rsv[i] = __builtin_amdgcn_rsqf(rs_raw(xs, i, fr) * (1.0f / 1024.0f) + NORM_EPS);
        asm volatile("" ::: "memory");
        u32x4 pa, pb;
        if (pn >= 4 && pn < 6) {
            bf16_t* const tile = P1 + kt_off(rowg, 512 + (pn - 4) * BM + wc * 64, 24) + (size_t)(lane >> 3) * 64 + (lane & 7) * 8;
#pragma unroll
            for (int ai = 0; ai < 2; ++ai)
#pragma unroll
                for (int m = 0; m < 4; ++m) {
                    const int i = ai * 4 + m; const float rs = rsv[i];
                    if (i > 0) { bf16_t* t0 = tile + (size_t)(((i - 1) >> 2) * HALF + ((i - 1) & 3) * 16) * 64; nt16(pa, t0); nt16(pb, t0 + 8 * 64); }
                    xp_put2(xs, fr, fq, pack8(acc[ai][0][m][0] * rs, acc[ai][0][m][1] * rs), pack8(acc[ai][1][m][0] * rs, acc[ai][1][m][1] * rs), pa, pb);
                }
            { bf16_t* t0 = tile + (size_t)(HALF + 3 * 16) * 64; nt16(pa, t0); nt16(pb, t0 + 8 * 64); }
        } else {
            const int col = (pn < 4 ? pn * HALF : 1024 + (pn - 6) * HALF) + wc * 32;
            bf16_t* const tile = P1 + kt_off(rowg, col, 24) + (size_t)(lane >> 2) * 64 + (lane & 3) * 8;
#pragma unroll
            for (int ai = 0; ai < 2; ++ai)
#pragma unroll
                for (int m = 0; m < 4; ++m) {
                    const int i = ai * 4 + m; const float rs = rsv[i]; f32x4 o[2];
                    if (pn < 4) {
#pragma unroll
                        for (int n = 0; n < 2; ++n) { const f32x4 a4 = acc[ai][0][m][n], g4 = acc[ai][1][m][n]; const float kq = -1.4426950408889634f * rs, irs1 = __builtin_amdgcn_rcpf(rs); const f32x2 irs = {irs1, irs1};
#pragma unroll
                            for (int h = 0; h < 2; ++h) { const f32x2 a = {a4[2 * h], a4[2 * h + 1]}, g = {g4[2 * h], g4[2 * h + 1]};
                                const f32x2 t = g * kq; f32x2 e; e.x = __builtin_amdgcn_exp2f(t.x); e.y = __builtin_amdgcn_exp2f(t.y);
                                const f32x2 d = __builtin_elementwise_fma(e, irs, irs); f32x2 r; r.x = __builtin_amdgcn_rcpf(d.x); r.y = __builtin_amdgcn_rcpf(d.y);
                                const f32x2 q = a * r; o[n][2 * h] = q.x; o[n][2 * h + 1] = q.y; } }
                    } else {
#pragma unroll
                        for (int n = 0; n < 2; ++n) o[n] = (acc[ai][0][m][n] * rs) * (acc[ai][1][m][n] * rs); }
                    if (i > 0) nt16(pa, tile + (size_t)(((i - 1) >> 2) * HALF + ((i - 1) & 3) * 16) * 64);
                    xp_put1(xs, fr, fq, pack8(o[0], o[1]), pa);
                }
            nt16(pa, tile + (size_t)(HALF + 3 * 16) * 64);
        }
    }
};

}

constexpr int NWAVES = 8;
constexpr int BATCH = 8, SEQ = 4096, DM = 1024, T = BATCH * SEQ;
constexpr int AB_IN = 5632, CD_IN = 2560, DFF = 2816, GU_N = 2 * DFF;
constexpr size_t MiB = 1u << 20;
constexpr size_t WS_CTL = 0, CTL_ZERO_BYTES = 32 * 1024;
constexpr size_t WS_ROPE = 1 * MiB;
constexpr size_t WS_DWTAB = WS_ROPE + 192 * 1024;
constexpr size_t WS_WSG = WS_ROPE + 256 * 1024;
constexpr size_t WS_RSS = WS_WSG + 128 * 1024;
constexpr size_t WS_LSE = 2 * MiB;
constexpr size_t WS_W0IN = 8 * MiB;
constexpr size_t WS_W0OUT = 19 * MiB;
constexpr size_t WS_W0GU = 21 * MiB;
constexpr size_t WS_W0D = 32 * MiB;
constexpr size_t WS_W1IN = 38 * MiB;
constexpr size_t WS_W1OUT = 43 * MiB;
constexpr size_t WS_W1GU = 45 * MiB;
constexpr size_t WS_W1D = 56 * MiB;
constexpr size_t WS_XB = 64 * MiB;
constexpr size_t WS_UV = 128 * MiB;
constexpr size_t WS_Q = 192 * MiB;
constexpr size_t WS_K = 288 * MiB;
constexpr size_t WS_V = 384 * MiB;
constexpr size_t WS_ACT = WS_Q;
constexpr size_t WS_P1 = 368 * MiB;
constexpr size_t WS_AB = WS_K, WS_CD = WS_UV;
constexpr size_t WS_END = 480 * MiB;
constexpr int CW_BAR = 4096;

constexpr int RING_OFF = 0, RING_BYTES = 131072;
constexpr int LDSCTL_OFF = RING_BYTES, MISC_OFF = LDSCTL_OFF + 320;
constexpr int AUX_OFF = LDSCTL_OFF + 1024;
constexpr int XP_OFF = AUX_OFF + 2048;
constexpr int LDS_BYTES = 155648;
static_assert(XP_OFF + 8 * 2304 <= LDS_BYTES, "LDS map");
#define GAS __attribute__((address_space(1)))
#define LAS __attribute__((address_space(3)))
typedef unsigned short bf16;
typedef unsigned v4u __attribute__((ext_vector_type(4)));
typedef float f32x4 __attribute__((ext_vector_type(4)));
typedef short bf16x8 __attribute__((ext_vector_type(8)));
typedef GAS unsigned gu32;
typedef GAS unsigned long long gu64;
#define RLX_AGENT __ATOMIC_RELAXED, __HIP_MEMORY_SCOPE_AGENT
#define LDS_WAIT() asm volatile("s_waitcnt lgkmcnt(0)" ::: "memory")
#define VM_WAIT() asm volatile("s_waitcnt vmcnt(0)" ::: "memory")
__device__ __forceinline__ unsigned long long rt() { return __builtin_amdgcn_s_memrealtime(); }
__device__ __forceinline__ unsigned f2bf(float f) { unsigned u = __builtin_bit_cast(unsigned, f); return (u + 0x7fffu + ((u >> 16) & 1u)) >> 16; }
__device__ __forceinline__ unsigned pk2(float lo, float hi) { return f2bf(lo) | (f2bf(hi) << 16); }

#define XB_TMO      128
#define XB_XCNT(j)  (256  + 64 * (j))
#define XB_XSUB(j)  (1280 + 64 * (j))
#define XB_XGEN(j)  (2304 + 64 * (j))
#define XB_TOP      3328
#define XB_TOPGEN   3392
#define XCD_BAR_WORDS 3456
#define XB_SPIN_CAP (1u << 18)

__device__ __forceinline__ unsigned xb_ld(unsigned* p)              { return __hip_atomic_load(p, __ATOMIC_RELAXED, __HIP_MEMORY_SCOPE_AGENT); }
__device__ __forceinline__ unsigned xb_add(unsigned* p, unsigned v) { return __hip_atomic_fetch_add(p, v, __ATOMIC_RELAXED, __HIP_MEMORY_SCOPE_AGENT); }
__device__ __forceinline__ unsigned xb_xcc_id() { return (unsigned)__builtin_amdgcn_s_getreg((3 << 11) | 20) & 0xFu; }
#define XB_SPIN(cond, bar) do { unsigned _sp = 0; while (cond) { __builtin_amdgcn_s_sleep(1); \
    if ((++_sp & 255u) == 0u) { if (xb_ld(&(bar)[XB_TMO])) break; if (_sp > XB_SPIN_CAP) { atomicAdd(&(bar)[XB_TMO], 1u); break; } } } } while (0)

struct XcdBarrier {
    unsigned* bar; unsigned x;
    volatile LAS unsigned* st;
};

__device__ __forceinline__ XcdBarrier xcd_barrier_post(unsigned* bar, volatile LAS unsigned* st) {
    XcdBarrier b; b.bar = bar; b.x = xb_xcc_id(); b.st = st;
    if (threadIdx.x == 0) (void)xb_add(&bar[XB_XCNT(b.x)], 1u);
    return b;
}
__device__ __forceinline__ void xcd_barrier_complete(unsigned* bar, unsigned x, unsigned& nloc, unsigned& nx) {
    const unsigned G = gridDim.x * gridDim.y * gridDim.z;
    unsigned sum, cnt, mine, sp = 0u;
    for (;;) {
        sum = 0u; cnt = 0u; mine = 0u;
#pragma unroll
        for (unsigned j = 0; j < 16; ++j) { const unsigned c = xb_ld(&bar[XB_XCNT(j)]); sum += c; cnt += (c > 0u) ? 1u : 0u; mine = (j == x) ? c : mine; }
        if (sum == G) break;
        __builtin_amdgcn_s_sleep(1);
        if ((++sp & 255u) == 0u) { if (xb_ld(&bar[XB_TMO])) break; if (sp > XB_SPIN_CAP) { atomicAdd(&bar[XB_TMO], 1u); break; } }
    }
    nloc = mine > 0u ? mine : 1u; nx = cnt > 0u ? cnt : 1u;
}

__device__ __forceinline__ void xcd_barrier(const XcdBarrier& b) {
    asm volatile("s_waitcnt vmcnt(0)" ::: "memory");
    __syncthreads();
    if (threadIdx.x == 0) {
        unsigned* bar = b.bar;
        __builtin_amdgcn_s_waitcnt(0);
        unsigned nloc = b.st[0], nx = b.st[1];
        if (nloc == 0u) { xcd_barrier_complete(bar, b.x, nloc, nx); b.st[0] = nloc; b.st[1] = nx; }
        const unsigned old = xb_add(&bar[XB_XSUB(b.x)], 1u);
        const unsigned gen = old / nloc;
        if (old + 1u == (gen + 1u) * nloc) {
            __builtin_amdgcn_fence(__ATOMIC_RELEASE, "agent");
            asm volatile("s_waitcnt vmcnt(0)" ::: "memory");
            const unsigned og = xb_add(&bar[XB_TOP], 1u);
            const unsigned tg = og / nx;
            if (og + 1u == (tg + 1u) * nx) xb_add(&bar[XB_TOPGEN], 1u);
            else XB_SPIN(xb_ld(&bar[XB_TOPGEN]) == tg, bar);
            __builtin_amdgcn_fence(__ATOMIC_ACQUIRE, "agent");
            xb_add(&bar[XB_XGEN(b.x)], 1u);
            asm volatile("s_waitcnt vmcnt(0)" ::: "memory");
        } else {
            XB_SPIN(xb_ld(&bar[XB_XGEN(b.x)]) == gen, bar);
            __builtin_amdgcn_fence(__ATOMIC_ACQUIRE, "agent");
            asm volatile("s_waitcnt vmcnt(0)" ::: "memory");
        }
    }
    __syncthreads();
}

typedef unsigned u32x2 __attribute__((ext_vector_type(2)));
typedef float f32x16 __attribute__((ext_vector_type(16)));
typedef short s16x4 __attribute__((ext_vector_type(4)));
struct Frame {
    LAS unsigned char* lds;
    volatile LAS unsigned* MISC;
    gu32* ctl;
    int wave;
    int vcu, G;
    const float* in[22];
    float* out;
    unsigned char* ws;
};
__device__ __forceinline__ float wave_sum(float v) {
#pragma unroll
    for (int o = 1; o < 64; o <<= 1) v += __shfl_xor(v, o);
    return v;
}
__device__ __forceinline__ int red16_idx(int lane) { return ((lane >> 5) & 1) * 8 + ((lane >> 4) & 1) * 4 + ((lane >> 3) & 1) * 2 + ((lane >> 2) & 1); }
template <int H, int MSK> __device__ __forceinline__ void red16_step(float (&v)[16], int lane) { const bool up = (lane & MSK) != 0;
#pragma unroll
    for (int i = 0; i < H; ++i) { const float send = up ? v[i] : v[i + H], keep = up ? v[i + H] : v[i]; v[i] = keep + __shfl_xor(send, MSK); } }
__device__ __forceinline__ void reduce16(float (&v)[16], int lane) {
    red16_step<8, 32>(v, lane); red16_step<4, 16>(v, lane); red16_step<2, 8>(v, lane); red16_step<1, 4>(v, lane);
    v[0] += __shfl_xor(v[0], 2); v[0] += __shfl_xor(v[0], 1);
}
__device__ __forceinline__ unsigned cvtpk_s(float lo, float hi) { typedef float f2_t __attribute__((ext_vector_type(2))); typedef __bf16 b2_t __attribute__((ext_vector_type(2)));
    f2_t v = {lo, hi}; b2_t b = __builtin_convertvector(v, b2_t); return __builtin_bit_cast(unsigned, b); }
__device__ __forceinline__ float bf_lo(unsigned w) { return __builtin_bit_cast(float, w << 16); }
__device__ __forceinline__ float bf_hi(unsigned w) { return __builtin_bit_cast(float, w & 0xffff0000u); }

__device__ __forceinline__ int p0_perm256(int n) { const int o = n & 255; return (n & ~255) + ((o >> 5) & 1) * 128 + (o >> 6) * 32 + (o & 31); }
__device__ __forceinline__ int p0_drow(int kind, int n) {
    if (kind == 2) return 256 * (n >> 7) + (n & 127);
    if (kind == 3) { if (n < 512) return 256 * (n >> 7) + (n & 127);
        if (n < 1024) { const int n1 = n - 512; return 256 * (n1 >> 7) + 128 + (n1 & 127); }
        if (n < 1536) return p0_perm256(n);
        if (n < 2048) { const int n1 = n - 1536; return 1536 + 256 * (n1 >> 7) + (n1 & 127); }
        const int n1 = n - 2048; return 1536 + 256 * (n1 >> 7) + 128 + (n1 & 127); }
    return p0_perm256(n);
}
__device__ __forceinline__ void p0_item(const float* W, int K, int N, int k0, int n0, bf16* WT, int kind, int radd, const float* gain, LAS unsigned char* scr, int lane) {
    const int n4 = (lane & 15) * 4, kr = lane >> 4;
    f32x4 v[16]; float gv[16];
#pragma unroll
    for (int i = 0; i < 16; ++i) { v[i] = __builtin_nontemporal_load((const GAS f32x4*)(W + (size_t)(k0 + 4 * i + kr) * N + n0 + n4)); gv[i] = gain ? gain[k0 + 4 * i + kr] : 1.0f; }
#pragma unroll
    for (int i = 0; i < 16; ++i) { const f32x4 x = v[i] * gv[i]; LAS unsigned* d = (LAS unsigned*)(scr + (4 * i + kr) * 132 + n4 * 2); d[0] = pk2(x.x, x.y); d[1] = pk2(x.z, x.w); }
    LDS_WAIT(); asm volatile("" ::: "memory");
    const int kc = lane & 7, nr = lane >> 3;
#pragma unroll
    for (int j = 0; j < 8; ++j) { const int n = nr + 8 * j; const LAS unsigned short* sp = (const LAS unsigned short*)(scr + (8 * kc) * 132 + n * 2);
        v4u o; o.x = (unsigned)sp[0] | ((unsigned)sp[66] << 16); o.y = (unsigned)sp[132] | ((unsigned)sp[198] << 16); o.z = (unsigned)sp[264] | ((unsigned)sp[330] << 16); o.w = (unsigned)sp[396] | ((unsigned)sp[462] << 16);
        const int nd = p0_drow(kind, n0 + n) + radd;
        *(GAS v4u*)(WT + pg8::img_off((nd & ~31) + pg8::invperm32(nd & 31), k0 + 8 * kc, K >> 6)) = o; }
    LDS_WAIT(); asm volatile("" ::: "memory");
}
__device__ __forceinline__ void p0_prologue(Frame& F) {
    LAS unsigned char* scr = F.lds + RING_OFF + F.wave * 16384;
    const int lane = mk_lane_id(); const int gw = F.vcu * NWAVES + F.wave, NGW = F.G * NWAVES;
    unsigned char* ws = F.ws;
    constexpr int I_IN0 = 16 * (AB_IN / 64), I_SQ = 16 * 16, I_GU = 16 * (DFF / 64), I_DN = (DFF / 64) * 16, I_IN1 = 16 * (CD_IN / 64);
    constexpr int NITEMS = I_IN0;
    for (int it = gw; it < NITEMS; it += NGW) {
        int r = it;
        if (r < I_IN0) { const int nblk = AB_IN / 64; p0_item(F.in[2], 1024, AB_IN, 64 * (r / nblk), 64 * (r % nblk), (bf16*)(ws + WS_W0IN), 1, 0, F.in[1], scr, lane); continue; }
    }
    if (gw == 0 && lane == 0) {
        pg8::DwTab* tab = (pg8::DwTab*)(ws + WS_DWTAB); const float* ones = (const float*)(ws + WS_DWTAB + 4096);
        tab[0] = pg8::DwTab{F.in[21], ones, (bf16*)(ws + WS_W0D), nullptr};
        tab[1] = pg8::DwTab{F.in[11], F.in[10], (bf16*)(ws + WS_W1IN), nullptr};
        tab[2] = pg8::DwTab{F.in[17], ones, (bf16*)(ws + WS_W1OUT), nullptr};
        tab[3] = pg8::DwTab{F.in[19] + (size_t)1024 * DFF, F.in[18] + 1024, (bf16*)(ws + WS_W1GU), nullptr};
        tab[4] = pg8::DwTab{F.in[20] + (size_t)1024 * DFF, F.in[18] + 1024, (bf16*)(ws + WS_W1GU), nullptr};
        tab[5] = pg8::DwTab{F.in[21] + (size_t)DFF * 1024, ones, (bf16*)(ws + WS_W1D), nullptr};
        tab[6] = pg8::DwTab{F.in[9], ones, (bf16*)(ws + WS_W0OUT), nullptr};
        tab[7] = pg8::DwTab{F.in[19], F.in[18], (bf16*)(ws + WS_W0GU), nullptr};
        tab[8] = pg8::DwTab{F.in[20], F.in[18], (bf16*)(ws + WS_W0GU), nullptr};
    }
    float* rss = (float*)(ws + WS_RSS); bf16* XB = (bf16*)(ws + WS_XB);
    for (int m0 = gw * 16; m0 < T; m0 += NGW * 16) {
        const int fr = lane & 15, fq = lane >> 4, ob = fr * 64 + fq * 16, sw = ob ^ (((ob >> 9) & 1) << 5);
        const GAS f32x4* xr = (const GAS f32x4*)(F.in[0] + (size_t)(m0 + fr) * DM + fq * 8);
        bf16* const xo = XB + pg8::img_off(m0, 0, 16) + (sw >> 1);
        float ss = 0.f;
#pragma unroll
        for (int cb = 0; cb < 4; ++cb) {
            f32x4 v[8][2];
#pragma unroll
            for (int c = 0; c < 8; ++c) { v[c][0] = __builtin_nontemporal_load(xr + (cb * 8 + c) * 8); v[c][1] = __builtin_nontemporal_load(xr + (cb * 8 + c) * 8 + 1); }
#pragma unroll
            for (int c = 0; c < 8; ++c) { const f32x4 a = v[c][0], b2 = v[c][1]; const int cg = cb * 8 + c;
                ss += ((a.x * a.x + a.y * a.y) + (a.z * a.z + a.w * a.w)) + ((b2.x * b2.x + b2.y * b2.y) + (b2.z * b2.z + b2.w * b2.w));
                v4u o; o.x = pk2(a.x, a.y); o.y = pk2(a.z, a.w); o.z = pk2(b2.x, b2.y); o.w = pk2(b2.z, b2.w);
                *(GAS v4u*)(xo + (cg >> 1) * 16384 + (cg & 1) * 512) = o; }
        }
        ss += __shfl_xor(ss, 16); ss += __shfl_xor(ss, 32);
        if (fq == 0) rss[m0 + fr] = ss;
    }
    const int gt = gw * 64 + lane, NGT = NGW * 64;
    for (int i = gt; i < DFF; i += NGT) ((float*)(ws + WS_DWTAB + 4096))[i] = 1.0f;
    for (int i = gt; i < 3 * T; i += NGT) rss[T + i] = 0.f;
    float* rope = (float*)(ws + WS_ROPE);
    for (int i = gt; i < SEQ * 8 + 8; i += NGT) { const int pos = i >> 3, k = i & 7; const float inv = exp2f(-2.3664460711655218f * (float)k), ang = (float)pos * inv;
        ((unsigned*)rope)[i] = pos < SEQ ? pk2(cosf(ang), sinf(ang)) : 0x00003f80u; }
    bf16* wsg = (bf16*)(ws + WS_WSG); const float* sw = F.in[5];
    for (int i = gt; i < 4 * 128 * 128; i += NGT) { const int g = i >> 14, t = (i >> 7) & 127, s = i & 127;
        wsg[((((g * 4 + (t >> 5)) * 8 + (s >> 4)) * 64 + ((s >> 3) & 1) * 32 + (t & 31)) << 3) + (s & 7)] = (bf16)(s <= t ? f2bf(sw[i]) : 0u); }
}

namespace att {
constexpr int KCH = 6160, LDS_KO = 0, LDS_VO = 8 * KCH, NUNITS = 3 * BATCH * 8 * 16;
__device__ __forceinline__ s16x4 vtr(const LAS unsigned char* p) { return __builtin_bit_cast(s16x4, __builtin_amdgcn_ds_read_tr16_b64_v4i16((LAS s16x4*)p)); }
struct UnitAddr { int g, h, sh, qb, rowb, j0; size_t hb; };
__device__ __forceinline__ UnitAddr decode(int U) { UnitAddr a; a.g = U >> 10; const int rem = U & 1023, b = rem >> 7, cq = rem & 15; a.h = (rem >> 4) & 7;
    a.sh = 2 * a.g; const int nbs = 4 - a.sh, c = cq >> nbs; a.qb = cq & ((1 << nbs) - 1); a.j0 = 256 * a.qb - 128; a.rowb = b * SEQ + c; a.hb = ((size_t)((((a.g * 8 + b) * 8 + a.h) << 12) + (c << (12 - a.sh)))) * 64; return a; }
__device__ __forceinline__ void attn_load(int U, bool chained, const bf16* Qb, const bf16* Kb, const bf16* Vb, v4u (&kv)[6], v4u (&vv)[6], bf16x8 (&qr)[4], int tid, int wid, int lane) {
    const UnitAddr a = decode(U);
#pragma unroll
    for (int i = 0; i < 6; ++i) { const int idx = i * 512 + tid, key = idx >> 3, ch = idx & 7, j = a.j0 + key;
        kv[i] = (v4u){0u, 0u, 0u, 0u}; vv[i] = (v4u){0u, 0u, 0u, 0u};
        if (j >= 0 && !(chained && i < 2)) {
            const size_t off = a.hb + (size_t)j * 64 + ch * 8; kv[i] = __builtin_nontemporal_load((const GAS v4u*)(Kb + off)); vv[i] = __builtin_nontemporal_load((const GAS v4u*)(Vb + off)); } }
    const size_t qoff = a.hb + (size_t)(256 * a.qb + 32 * wid + (lane >> 3)) * 64 + (lane & 7) * 8;
#pragma unroll
    for (int k = 0; k < 4; ++k) qr[k] = __builtin_nontemporal_load((const GAS bf16x8*)(Qb + qoff + (size_t)k * 8 * 64));
}
__device__ __forceinline__ LAS unsigned char* wave_scr(LAS unsigned char* lds, int wid) { return lds + (wid < 7 ? LDS_VO + 49152 + wid * 4096 : XP_OFF); }
__device__ __forceinline__ void q_frags(LAS unsigned char* scr, const bf16x8 (&qn)[4], bf16x8 (&qr)[4], int lane) {
    const int r32 = lane & 31, hi = lane >> 5;
#pragma unroll
    for (int k = 0; k < 4; ++k) { const int row = 8 * k + (lane >> 3); *(LAS bf16x8*)(scr + row * 128 + (((lane & 7) ^ (row & 7)) << 4)) = qn[k]; }
#pragma unroll
    for (int d0 = 0; d0 < 4; ++d0) qr[d0] = *(const LAS bf16x8*)(scr + r32 * 128 + (((2 * d0 + hi) ^ (r32 & 7)) << 4));
}
__device__ __forceinline__ void attn_stage(LAS unsigned char* lds, int qb, bool chained, const v4u (&kv)[6], const v4u (&vv)[6], int tid) {
    const int rb = (256 * qb) % 384;
#pragma unroll
    for (int i = 0; i < 6; ++i) { if (chained && i < 2) continue;
        const int idx = i * 512 + tid, ch = idx & 7; int key = rb + (idx >> 3); if (key >= 384) key -= 384;
        *(LAS v4u*)(lds + LDS_KO + ch * KCH + key * 16) = kv[i];
        *(LAS v4u*)(lds + LDS_VO + ((key >> 3) * 2 + (ch >> 2)) * 512 + (key & 7) * 64 + (ch & 3) * 16) = vv[i]; }
}
__device__ __forceinline__ void attn_compute(LAS unsigned char* lds, int U, const bf16x8 (&qr)[4], bf16* Ob, float* LSE, int wid, int lane) {
    const UnitAddr a = decode(U); const int qb = a.qb;
    const int r32 = lane & 31, hi = lane >> 5;
    const size_t qrow = (size_t)(a.rowb + ((256 * qb + 32 * wid + r32) << a.sh));
    const int tb0 = ((8 * qb) % 12 + wid) % 12;
    f32x16 p[5];
#pragma unroll
    for (int kt = 0; kt < 5; ++kt) {
        const bool ex = (qb > 0) || (wid + kt >= 4);
        const int ts = (tb0 + kt >= 12) ? tb0 + kt - 12 : tb0 + kt;
        if (ex) { f32x16 acc = {}; const LAS unsigned char* kp = lds + LDS_KO + hi * KCH + (32 * ts + r32) * 16;
#pragma unroll
            for (int d0 = 0; d0 < 4; ++d0) acc = __builtin_amdgcn_mfma_f32_32x32x16_bf16(*(const LAS bf16x8*)(kp + d0 * 2 * KCH), qr[d0], acc, 0, 0, 0);
            p[kt] = acc;
        } else {
#pragma unroll
            for (int r = 0; r < 16; ++r) p[kt][r] = -INFINITY; }
    }
#pragma unroll
    for (int r = 0; r < 16; ++r) { const int cr = (r & 3) + 8 * (r >> 2) + 4 * hi; if (cr < r32) p[0][r] = -INFINITY; if (cr > r32) p[4][r] = -INFINITY; }
    float m = -INFINITY;
#pragma unroll
    for (int kt = 0; kt < 5; ++kt)
#pragma unroll
        for (int r = 0; r < 16; ++r) m = fmaxf(m, p[kt][r]);
    m = fmaxf(m, __shfl_xor(m, 32));
    float l = 0.f;
#pragma unroll
    for (int kt = 0; kt < 5; ++kt)
#pragma unroll
        for (int r = 0; r < 16; ++r) { p[kt][r] = __builtin_amdgcn_exp2f(p[kt][r] - m); l += p[kt][r]; }
    l += __shfl_xor(l, 32);
    f32x16 o0 = {}, o1 = {};
    const int gi = lane >> 4, q_ = (lane & 15) >> 2, p_ = lane & 3;
    const LAS unsigned char* vbase = lds + LDS_VO + (4 * hi + q_) * 64 + (gi & 1) * 32 + p_ * 8;
#pragma unroll
    for (int kt = 0; kt < 5; ++kt) {
        const bool ex = (qb > 0) || (wid + kt >= 4);
        const int ts = (tb0 + kt >= 12) ? tb0 + kt - 12 : tb0 + kt;
        if (ex) {
#pragma unroll
            for (int s = 0; s < 2; ++s) {
                v4u pw; pw.x = cvtpk_s(p[kt][8 * s + 0], p[kt][8 * s + 1]); pw.y = cvtpk_s(p[kt][8 * s + 2], p[kt][8 * s + 3]); pw.z = cvtpk_s(p[kt][8 * s + 4], p[kt][8 * s + 5]); pw.w = cvtpk_s(p[kt][8 * s + 6], p[kt][8 * s + 7]);
                const bf16x8 pb = __builtin_bit_cast(bf16x8, pw);
                const LAS unsigned char* vp = vbase + (4 * ts + 2 * s) * 1024;
                const s16x4 a00 = vtr(vp), a01 = vtr(vp + 1024), a10 = vtr(vp + 512), a11 = vtr(vp + 1536);
                const bf16x8 A0 = (bf16x8){a00[0], a00[1], a00[2], a00[3], a01[0], a01[1], a01[2], a01[3]}, A1 = (bf16x8){a10[0], a10[1], a10[2], a10[3], a11[0], a11[1], a11[2], a11[3]};
                o0 = __builtin_amdgcn_mfma_f32_32x32x16_bf16(A0, pb, o0, 0, 0, 0); o1 = __builtin_amdgcn_mfma_f32_32x32x16_bf16(A1, pb, o1, 0, 0, 0);
            }
        }
    }
    const float inv = 1.0f / l;
    LAS unsigned char* scr = wave_scr(lds, wid);
#pragma unroll
    for (int rg = 0; rg < 4; ++rg) {
        u32x2 w0, w1; w0.x = cvtpk_s(o0[4 * rg] * inv, o0[4 * rg + 1] * inv); w0.y = cvtpk_s(o0[4 * rg + 2] * inv, o0[4 * rg + 3] * inv);
        w1.x = cvtpk_s(o1[4 * rg] * inv, o1[4 * rg + 1] * inv); w1.y = cvtpk_s(o1[4 * rg + 2] * inv, o1[4 * rg + 3] * inv);
        *(LAS u32x2*)(scr + r32 * 128 + ((rg ^ (r32 & 7)) << 4) + 8 * hi) = w0; *(LAS u32x2*)(scr + r32 * 128 + (((4 + rg) ^ (r32 & 7)) << 4) + 8 * hi) = w1; }
    bf16* op = Ob + a.hb + (size_t)(256 * qb + 32 * wid + (lane >> 3)) * 64 + (lane & 7) * 8;
#pragma unroll
    for (int k = 0; k < 4; ++k) { const int row = 8 * k + (lane >> 3); const v4u v = *(const LAS v4u*)(scr + row * 128 + (((lane & 7) ^ (row & 7)) << 4)); *(GAS v4u*)(op + (size_t)k * 8 * 64) = v; }
    if (hi == 0) LSE[((size_t)a.g * T + qrow) * 8 + a.h] = m + __builtin_amdgcn_logf(l);
}
__device__ __forceinline__ void attn_phase(LAS unsigned char* lds, int vcu, int G, const bf16* Qb, const bf16* Kb, const bf16* Vb, bf16* Ob, float* LSE, int wid) {
    int lane = mk_lane_id(); asm volatile("" : "+v"(lane)); const int tid = wid * 64 + lane;
    v4u kv[6], vv[6]; bf16x8 qn[4], qr[4];
    if (G == 256) {
        attn_load(4 * vcu, false, Qb, Kb, Vb, kv, vv, qn, tid, wid, lane);
        for (int s = 0; s < 12; ++s) { const int U = (s >> 2) * 1024 + 4 * vcu + (s & 3); const bool chained = (s < 8) && ((s & 3) != 0);
            attn_stage(lds, decode(U).qb, chained, kv, vv, tid);
            q_frags(wave_scr(lds, wid), qn, qr, lane);
            __syncthreads();
            if (s + 1 < 12) { const int Un = ((s + 1) >> 2) * 1024 + 4 * vcu + ((s + 1) & 3); attn_load(Un, (s + 1 < 8) && (((s + 1) & 3) != 0), Qb, Kb, Vb, kv, vv, qn, tid, wid, lane); }
            attn_compute(lds, U, qr, Ob, LSE, wid, lane);
            __syncthreads();
        }
        return;
    }
    if (vcu >= NUNITS) return;
    attn_load(vcu, false, Qb, Kb, Vb, kv, vv, qn, tid, wid, lane);
    for (int U = vcu; U < NUNITS; U += G) {
        attn_stage(lds, decode(U).qb, false, kv, vv, tid);
        q_frags(wave_scr(lds, wid), qn, qr, lane);
        __syncthreads();
        if (U + G < NUNITS) attn_load(U + G, false, Qb, Kb, Vb, kv, vv, qn, tid, wid, lane);
        attn_compute(lds, U, qr, Ob, LSE, wid, lane);
        __syncthreads();
    }
}
}

__device__ __forceinline__ void sg_unit(Frame& F, int unit) {
    LAS unsigned char* lds = F.lds; int lane = mk_lane_id(); asm volatile("" : "+v"(lane)); const int wid = F.wave, tid = wid * 64 + lane;
    const int row0 = unit * 128;
    const bf16* UV = (const bf16*)(F.ws + WS_UV); bf16* AB = (bf16*)(F.ws + WS_AB); const bf16* OG = (const bf16*)(F.ws + WS_Q); const float* LSE = (const float*)(F.ws + WS_LSE);
    const bf16* wsg = (const bf16*)(F.ws + WS_WSG);
    v4u uu[16];
    LAS f32x4* wts = (LAS f32x4*)(lds + XP_OFF);
    {
        v4u raw[16]; float sm[16], sq[16];
#pragma unroll
        for (int tk = 0; tk < 16; ++tk) raw[tk] = __builtin_nontemporal_load((const GAS v4u*)(UV + pg8::kt_off(row0 + wid * 16 + tk, 512 + 8 * lane, 16)));
        float l0[2], l1[2], l2[2];
#pragma unroll
        for (int q = 0; q < 2; ++q) { const int pr = q * 512 + tid; const size_t row = (size_t)(row0 + (pr >> 3)); const int head = pr & 7;
            l0[q] = LSE[row * 8 + head]; l1[q] = LSE[((size_t)T + row) * 8 + head]; l2[q] = LSE[((size_t)2 * T + row) * 8 + head]; }
#pragma unroll
        for (int q = 0; q < 8; ++q) { const int idx = q * 512 + tid, t = idx >> 6, chunk = idx & 63; uu[q] = __builtin_nontemporal_load((const GAS v4u*)(UV + pg8::kt_off(row0 + t, chunk * 8, 16))); }
        const f32x4 ga = *(const f32x4*)(F.in[3] + 8 * lane), gb = *(const f32x4*)(F.in[3] + 8 * lane + 4), ba = *(const f32x4*)(F.in[4] + 8 * lane), bb = *(const f32x4*)(F.in[4] + 8 * lane + 4);
#pragma unroll
        for (int tk = 0; tk < 16; ++tk) { const float x0 = bf_lo(raw[tk].x), x1 = bf_hi(raw[tk].x), x2 = bf_lo(raw[tk].y), x3 = bf_hi(raw[tk].y), x4 = bf_lo(raw[tk].z), x5 = bf_hi(raw[tk].z), x6 = bf_lo(raw[tk].w), x7 = bf_hi(raw[tk].w);
            sm[tk] = ((x0 + x1) + (x2 + x3)) + ((x4 + x5) + (x6 + x7)); sq[tk] = ((x0 * x0 + x1 * x1) + (x2 * x2 + x3 * x3)) + ((x4 * x4 + x5 * x5) + (x6 * x6 + x7 * x7)); }
        reduce16(sm, lane); reduce16(sq, lane);
        LAS float* st = (LAS float*)(lds + AUX_OFF) + wid * 32;
        { const float mean = sm[0] * (1.0f / 512.0f), var = fmaxf(sq[0] * (1.0f / 512.0f) - mean * mean, 0.f);
          if ((lane & 3) == 0) { st[2 * red16_idx(lane)] = mean; st[2 * red16_idx(lane) + 1] = __builtin_amdgcn_rsqf(var + 1e-6f); } }
#pragma unroll
        for (int tk = 0; tk < 16; ++tk) { const int s = wid * 16 + tk; const float mean = st[2 * tk], rstd = st[2 * tk + 1];
            const float x0 = bf_lo(raw[tk].x) - mean, x1 = bf_hi(raw[tk].x) - mean, x2 = bf_lo(raw[tk].y) - mean, x3 = bf_hi(raw[tk].y) - mean, x4 = bf_lo(raw[tk].z) - mean, x5 = bf_hi(raw[tk].z) - mean, x6 = bf_lo(raw[tk].w) - mean, x7 = bf_hi(raw[tk].w) - mean;
            v4u o; o.x = cvtpk_s(x0 * rstd * ga[0] + ba[0], x1 * rstd * ga[1] + ba[1]); o.y = cvtpk_s(x2 * rstd * ga[2] + ba[2], x3 * rstd * ga[3] + ba[3]);
            o.z = cvtpk_s(x4 * rstd * gb[0] + bb[0], x5 * rstd * gb[1] + bb[1]); o.w = cvtpk_s(x6 * rstd * gb[2] + bb[2], x7 * rstd * gb[3] + bb[3]);
            *(LAS v4u*)(lds + ((s >> 3) * 16 + (lane >> 2)) * 512 + (s & 7) * 64 + (lane & 3) * 16) = o; }
#pragma unroll
        for (int q = 0; q < 2; ++q) { const int pr = q * 512 + tid;
            const float mx = fmaxf(l0[q], fmaxf(l1[q], l2[q])); const float w0 = __builtin_amdgcn_exp2f(l0[q] - mx), w1 = __builtin_amdgcn_exp2f(l1[q] - mx), w2 = __builtin_amdgcn_exp2f(l2[q] - mx);
            const float iv = 1.0f / (w0 + w1 + w2); wts[pr] = (f32x4){w0 * iv, w1 * iv, w2 * iv, 0.f}; }
    }
    __syncthreads();
    v4u ma[8], mb[8], mc[8];
#define SG_MLOAD(H, TID) _Pragma("unroll") for (int q = 0; q < 8; ++q) { const int idx = ((H) * 8 + q) * 512 + (TID), tk = idx >> 6, pc = idx & 63, head = pc >> 3; const size_t row = (size_t)(row0 + tk); \
        const int bb_ = (int)(row >> 12), tt_ = (int)(row & 4095), dd = (pc & 7) * 8; \
        ma[q] = __builtin_nontemporal_load((const GAS v4u*)(OG + pg8::hm_off(0, bb_, head, tt_) + dd)); mb[q] = __builtin_nontemporal_load((const GAS v4u*)(OG + pg8::hm_off(1, bb_, head, tt_) + dd)); \
        mc[q] = __builtin_nontemporal_load((const GAS v4u*)(OG + pg8::hm_off(2, bb_, head, tt_) + dd)); }
#define SG_MERGE(H, TID) _Pragma("unroll") for (int q = 0; q < 8; ++q) { const int idx = ((H) * 8 + q) * 512 + (TID), tk = idx >> 6, pc = idx & 63; const size_t row = (size_t)(row0 + tk); \
        const f32x4 w = wts[tk * 8 + (pc >> 3)]; const float w0 = w[0], w1 = w[1], w2 = w[2]; \
        v4u o; \
        o.x = cvtpk_s(w0 * bf_lo(ma[q].x) + w1 * bf_lo(mb[q].x) + w2 * bf_lo(mc[q].x), w0 * bf_hi(ma[q].x) + w1 * bf_hi(mb[q].x) + w2 * bf_hi(mc[q].x)); \
        o.y = cvtpk_s(w0 * bf_lo(ma[q].y) + w1 * bf_lo(mb[q].y) + w2 * bf_lo(mc[q].y), w0 * bf_hi(ma[q].y) + w1 * bf_hi(mb[q].y) + w2 * bf_hi(mc[q].y)); \
        o.z = cvtpk_s(w0 * bf_lo(ma[q].z) + w1 * bf_lo(mb[q].z) + w2 * bf_lo(mc[q].z), w0 * bf_hi(ma[q].z) + w1 * bf_hi(mb[q].z) + w2 * bf_hi(mc[q].z)); \
        o.w = cvtpk_s(w0 * bf_lo(ma[q].w) + w1 * bf_lo(mb[q].w) + w2 * bf_lo(mc[q].w), w0 * bf_hi(ma[q].w) + w1 * bf_hi(mb[q].w) + w2 * bf_hi(mc[q].w)); \
        *(GAS v4u*)(AB + pg8::img_off((int)row, 512 + pc * 8, 16)) = o; }
    {
        int lb_ = lane; asm volatile("" : "+v"(lb_));
        const int r32 = lb_ & 31, hi = lb_ >> 5, gi = lb_ >> 4, q_ = (lb_ & 15) >> 2, p_ = lb_ & 3;
        const int g = wid >> 1, ch0 = g * 128 + (wid & 1) * 64;
        f32x16 acc[2][4];
#pragma unroll
        for (int ct = 0; ct < 2; ++ct)
#pragma unroll
            for (int tt = 0; tt < 4; ++tt) acc[ct][tt] = (f32x16){};
        const LAS unsigned char* abase = lds + (hi * 16 + (ch0 >> 5)) * 512 + q_ * 64 + (gi & 1) * 32 + p_ * 8;
        const bf16* wb = wsg + ((size_t)(g * 4 * 8) * 64 + lb_) * 8;
#pragma unroll
        for (int ks = 0; ks < 8; ++ks) {
            bf16x8 A[2];
#pragma unroll
            for (int ct = 0; ct < 2; ++ct) { const s16x4 lo = att::vtr(abase + (2 * ks * 16 + ct) * 512), hh = att::vtr(abase + (2 * ks * 16 + ct) * 512 + 256);
                A[ct] = (bf16x8){lo[0], lo[1], lo[2], lo[3], hh[0], hh[1], hh[2], hh[3]}; }
#pragma unroll
            for (int tt = 0; tt < 4; ++tt) if (ks < 2 * (tt + 1)) {
                const bf16x8 B = *(const GAS bf16x8*)(wb + (size_t)((tt * 8 + ks) * 64) * 8);
#pragma unroll
                for (int ct = 0; ct < 2; ++ct) acc[ct][tt] = __builtin_amdgcn_mfma_f32_32x32x16_bf16(A[ct], B, acc[ct][tt], 0, 0, 0); }
        }
        const float* bias = F.in[6] + g * 128;
        __syncthreads();
#pragma unroll
        for (int tt = 0; tt < 4; ++tt) { const int t = 32 * tt + r32; const float bs = bias[t];
#pragma unroll
            for (int ct = 0; ct < 2; ++ct)
#pragma unroll
                for (int rg = 0; rg < 4; ++rg) { const int c = ch0 + 32 * ct + 8 * rg + 4 * hi;
                    u32x2 w; w.x = cvtpk_s(acc[ct][tt][4 * rg] + bs, acc[ct][tt][4 * rg + 1] + bs); w.y = cvtpk_s(acc[ct][tt][4 * rg + 2] + bs, acc[ct][tt][4 * rg + 3] + bs);
                    *(LAS u32x2*)(lds + t * 1024 + ((((c >> 3) ^ (t & 15)) << 4) | ((c & 4) << 1))) = w; } }
    }
    int lc_ = lane; asm volatile("" : "+v"(lc_)); const int tidc = wid * 64 + lc_;
#pragma unroll
    for (int q = 8; q < 16; ++q) { const int idx = q * 512 + tidc, t = idx >> 6, chunk = idx & 63; uu[q] = __builtin_nontemporal_load((const GAS v4u*)(UV + pg8::kt_off(row0 + t, chunk * 8, 16))); }
    SG_MLOAD(0, tidc)
    __syncthreads();
    int ld_ = lane; asm volatile("" : "+v"(ld_)); const int tidd = wid * 64 + ld_;
#pragma unroll
    for (int q = 0; q < 16; ++q) { const int idx = q * 512 + tidd, t = idx >> 6, chunk = idx & 63;
        const v4u m = *(const LAS v4u*)(lds + t * 1024 + ((chunk ^ (t & 15)) << 4)); v4u o;
        o.x = cvtpk_s(bf_lo(uu[q].x) * bf_lo(m.x), bf_hi(uu[q].x) * bf_hi(m.x)); o.y = cvtpk_s(bf_lo(uu[q].y) * bf_lo(m.y), bf_hi(uu[q].y) * bf_hi(m.y));
        o.z = cvtpk_s(bf_lo(uu[q].z) * bf_lo(m.z), bf_hi(uu[q].z) * bf_hi(m.z)); o.w = cvtpk_s(bf_lo(uu[q].w) * bf_lo(m.w), bf_hi(uu[q].w) * bf_hi(m.w));
        *(GAS v4u*)(AB + pg8::img_off(row0 + t, chunk * 8, 16)) = o; }
    int le_ = lane; asm volatile("" : "+v"(le_)); const int tide = wid * 64 + le_;
    SG_MERGE(0, tide)
    SG_MLOAD(1, tide)
    int lf_ = lane; asm volatile("" : "+v"(lf_)); const int tidf = wid * 64 + lf_;
    SG_MERGE(1, tidf)
#undef SG_MLOAD
#undef SG_MERGE
    __syncthreads();
}

typedef float f32x2 __attribute__((ext_vector_type(2)));
__device__ __forceinline__ f32x2 bf_pair(unsigned w) { return (f32x2){bf_lo(w), bf_hi(w)}; }
__device__ __forceinline__ void conv_pair(Frame& F, int pair) {
    LAS unsigned char* lds = F.lds; int lane = mk_lane_id(); asm volatile("" : "+v"(lane)); const int wid = F.wave, tid = wid * 64 + lane;
    const int b = pair >> 5, tA = (pair & 31) * 128;
    const bf16* P1 = (const bf16*)(F.ws + WS_P1); bf16* CD = (bf16*)(F.ws + WS_CD);
    {
        v4u v[12];
#pragma unroll
        for (int i = 0; i < 12; ++i) { const int idx = i * 512 + tid, r = idx >> 6, pc = idx & 63, t = tA - 30 + r; v[i] = (v4u){0u, 0u, 0u, 0u};
            if (idx < 94 * 64 && t >= 0) v[i] = *(const GAS v4u*)(P1 + pg8::kt_off(b * SEQ + t, pc * 8, 24)); }
        f32x4 wv[8];
#pragma unroll
        for (int i = 0; i < 8; ++i) { const int idx = i * 512 + tid; wv[i] = (f32x4){0.f, 0.f, 0.f, 0.f}; if (idx < 31 * 128) wv[i] = *(const GAS f32x4*)(F.in[12] + (size_t)idx * 4); }
#pragma unroll
        for (int i = 0; i < 12; ++i) { const int idx = i * 512 + tid, r = idx >> 6, pc = idx & 63; if (idx < 94 * 64) *(LAS v4u*)(lds + r * 1024 + pc * 16) = v[i]; }
#pragma unroll
        for (int i = 0; i < 8; ++i) { const int idx = i * 512 + tid; if (idx < 31 * 128) { u32x2 w; w.x = cvtpk_s(wv[i][0], wv[i][1]); w.y = cvtpk_s(wv[i][2], wv[i][3]); *(LAS u32x2*)(lds + 94 * 1024 + idx * 8) = w; } }
    }
    __syncthreads();
    const LAS unsigned char* wrow = lds + 94 * 1024 + lane * 16;
#pragma nounroll
    for (int half = 0; half < 2; ++half) {
        int ln = lane; asm volatile("" : "+v"(ln)); const int c0 = 8 * ln;
        const int t0 = tA + 64 * half, row0 = b * SEQ + t0, tw = t0 + 8 * wid;
        const int rwrap = half ? 30 - 8 * wid : 0;
        const LAS unsigned char* xlo = lds + (8 * wid + 64) * 1024 + ln * 16;
        const LAS unsigned char* xhi = lds + (8 * wid - (half ? 30 : 0)) * 1024 + ln * 16;
        v4u gx[10], gg[8];
#pragma unroll
        for (int i = 0; i < 10; ++i) { const int t = tw - 2 + i; gx[i] = (v4u){0u, 0u, 0u, 0u}; if (t >= 0) gx[i] = *(const GAS v4u*)(P1 + pg8::kt_off(b * SEQ + t, 1024 + c0, 24)); }
        f32x2 acc[8][4];
        { const f32x4 ba = *(const GAS f32x4*)(F.in[13] + c0), bb = *(const GAS f32x4*)(F.in[13] + c0 + 4);
#pragma unroll
          for (int o = 0; o < 8; ++o) { acc[o][0] = (f32x2){ba[0], ba[1]}; acc[o][1] = (f32x2){ba[2], ba[3]}; acc[o][2] = (f32x2){bb[0], bb[1]}; acc[o][3] = (f32x2){bb[2], bb[3]}; } }
        asm volatile("" ::: "memory");
        f32x2 wt[8][4];
#define XADDR(r) (((r) < rwrap ? xlo : xhi) + (r) * 1024)
        v4u xq = *(const LAS v4u*)XADDR(0), wq = *(const LAS v4u*)(wrow);
#define CONV_ROW(r) { \
        const v4u xr = xq, wp = wq; \
        if ((r) + 1 < 38) xq = *(const LAS v4u*)XADDR((r) + 1); \
        if ((r) + 1 <= 30) wq = *(const LAS v4u*)(wrow + ((r) + 1) * 1024); \
        if ((r) <= 30) { wt[(r) & 7][0] = bf_pair(wp.x); wt[(r) & 7][1] = bf_pair(wp.y); wt[(r) & 7][2] = bf_pair(wp.z); wt[(r) & 7][3] = bf_pair(wp.w); } \
        const f32x2 x0 = bf_pair(xr.x), x1 = bf_pair(xr.y), x2 = bf_pair(xr.z), x3 = bf_pair(xr.w); \
        _Pragma("unroll") for (int o = 0; o < 8; ++o) { const int j = (r) - o; if (j >= 0 && j <= 30) { \
            acc[o][0] = __builtin_elementwise_fma(wt[j & 7][0], x0, acc[o][0]); acc[o][1] = __builtin_elementwise_fma(wt[j & 7][1], x1, acc[o][1]); \
            acc[o][2] = __builtin_elementwise_fma(wt[j & 7][2], x2, acc[o][2]); acc[o][3] = __builtin_elementwise_fma(wt[j & 7][3], x3, acc[o][3]); \
            asm volatile("" : "+v"(acc[o][0]), "+v"(acc[o][1]), "+v"(acc[o][2]), "+v"(acc[o][3])); } } \
        asm volatile("" ::: "memory"); }
        CONV_ROW(0) CONV_ROW(1) CONV_ROW(2) CONV_ROW(3) CONV_ROW(4) CONV_ROW(5) CONV_ROW(6) CONV_ROW(7)
        CONV_ROW(8) CONV_ROW(9) CONV_ROW(10) CONV_ROW(11) CONV_ROW(12) CONV_ROW(13) CONV_ROW(14) CONV_ROW(15)
        CONV_ROW(16) CONV_ROW(17) CONV_ROW(18) CONV_ROW(19) CONV_ROW(20) CONV_ROW(21) CONV_ROW(22) CONV_ROW(23)
        CONV_ROW(24) CONV_ROW(25) CONV_ROW(26) CONV_ROW(27) CONV_ROW(28) CONV_ROW(29) CONV_ROW(30) CONV_ROW(31)
        CONV_ROW(32) CONV_ROW(33) CONV_ROW(34) CONV_ROW(35) CONV_ROW(36) CONV_ROW(37)
#undef CONV_ROW
#undef XADDR
        asm volatile("" ::: "memory");
        int l2 = ln; asm volatile("" : "+v"(l2)); const int c1 = 8 * l2, tid2 = wid * 64 + l2;
#pragma unroll
        for (int o = 0; o < 8; ++o) gg[o] = *(const GAS v4u*)(P1 + pg8::kt_off(b * SEQ + tw + o, 512 + c1, 24));
        v4u nb[8];
        if (half == 0) {
#pragma unroll
            for (int i = 0; i < 8; ++i) { const int idx = i * 512 + tid2, r = idx >> 6, pc = idx & 63; nb[i] = *(const GAS v4u*)(P1 + pg8::kt_off(b * SEQ + tA + 64 + r, pc * 8, 24)); }
        }
        float st[16];
#pragma unroll
        for (int o = 0; o < 8; ++o) { float s1 = 0.f, s2 = 0.f;
#pragma unroll
            for (int c = 0; c < 4; ++c) { s1 += acc[o][c][0] + acc[o][c][1]; s2 += acc[o][c][0] * acc[o][c][0] + acc[o][c][1] * acc[o][c][1]; }
            st[o] = s1; st[8 + o] = s2; }
        reduce16(st, l2);
        LAS float* sw = (LAS float*)(lds + AUX_OFF) + wid * 16;
        if ((l2 & 3) == 0) sw[red16_idx(l2)] = st[0];
        asm volatile("" ::: "memory");
        const f32x4 ga = *(const GAS f32x4*)(F.in[14] + c1), gb = *(const GAS f32x4*)(F.in[14] + c1 + 4), la = *(const GAS f32x4*)(F.in[15] + c1), lb = *(const GAS f32x4*)(F.in[15] + c1 + 4);
        const float lg[8] = {ga[0], ga[1], ga[2], ga[3], gb[0], gb[1], gb[2], gb[3]}, lbv[8] = {la[0], la[1], la[2], la[3], lb[0], lb[1], lb[2], lb[3]};
#pragma unroll
        for (int o = 0; o < 8; ++o) { const float mean = sw[o] * (1.0f / 512.0f), var = fmaxf(sw[8 + o] * (1.0f / 512.0f) - mean * mean, 0.f), rstd = __builtin_amdgcn_rsqf(var + 1e-6f);
            float y[8];
#pragma unroll
            for (int c = 0; c < 8; ++c) { const float z = (acc[o][c >> 1][c & 1] - mean) * rstd * lg[c] + lbv[c]; y[c] = z * pg8::sigmoid_f(z); }
            v4u ov; ov.x = cvtpk_s(y[0], y[1]); ov.y = cvtpk_s(y[2], y[3]); ov.z = cvtpk_s(y[4], y[5]); ov.w = cvtpk_s(y[6], y[7]);
            *(GAS v4u*)(CD + pg8::img_off(row0 + 8 * wid + o, c1, 16)) = ov; }
        asm volatile("" ::: "memory");
        { const GAS float* dw = (const GAS float*)F.in[16] + c1;
          const f32x4 d0a = *(const GAS f32x4*)(dw), d0b = *(const GAS f32x4*)(dw + 4), d1a = *(const GAS f32x4*)(dw + 512), d1b = *(const GAS f32x4*)(dw + 516), d2a = *(const GAS f32x4*)(dw + 1024), d2b = *(const GAS f32x4*)(dw + 1028);
          const float w0[8] = {d0a[0], d0a[1], d0a[2], d0a[3], d0b[0], d0b[1], d0b[2], d0b[3]}, w1[8] = {d1a[0], d1a[1], d1a[2], d1a[3], d1b[0], d1b[1], d1b[2], d1b[3]}, w2[8] = {d2a[0], d2a[1], d2a[2], d2a[3], d2b[0], d2b[1], d2b[2], d2b[3]};
#pragma unroll
          for (int o = 0; o < 8; ++o) { const v4u xa = gx[o], xb = gx[o + 1], xc = gx[o + 2], gv = gg[o];
              const float A[8] = {bf_lo(xa.x), bf_hi(xa.x), bf_lo(xa.y), bf_hi(xa.y), bf_lo(xa.z), bf_hi(xa.z), bf_lo(xa.w), bf_hi(xa.w)}, B[8] = {bf_lo(xb.x), bf_hi(xb.x), bf_lo(xb.y), bf_hi(xb.y), bf_lo(xb.z), bf_hi(xb.z), bf_lo(xb.w), bf_hi(xb.w)};
              const float C[8] = {bf_lo(xc.x), bf_hi(xc.x), bf_lo(xc.y), bf_hi(xc.y), bf_lo(xc.z), bf_hi(xc.z), bf_lo(xc.w), bf_hi(xc.w)}, Gv[8] = {bf_lo(gv.x), bf_hi(gv.x), bf_lo(gv.y), bf_hi(gv.y), bf_lo(gv.z), bf_hi(gv.z), bf_lo(gv.w), bf_hi(gv.w)};
              float d[8];
#pragma unroll
              for (int c = 0; c < 8; ++c) d[c] = Gv[c] * (w0[c] * A[c] + w1[c] * B[c] + w2[c] * C[c]);
              v4u ov; ov.x = cvtpk_s(d[0], d[1]); ov.y = cvtpk_s(d[2], d[3]); ov.z = cvtpk_s(d[4], d[5]); ov.w = cvtpk_s(d[6], d[7]);
              *(GAS v4u*)(CD + pg8::img_off(row0 + 8 * wid + o, 512 + c1, 16)) = ov; } }
        __syncthreads();
        if (half == 0) {
#pragma unroll
            for (int i = 0; i < 8; ++i) { const int idx = i * 512 + tid2, r = idx >> 6, pc = idx & 63; *(LAS v4u*)(lds + r * 1024 + pc * 16) = nb[i]; }
            __syncthreads();
        }
    }
}

#ifndef MK_REP_SG
#define MK_REP_SG 1
#endif
#ifndef MK_REP_CONV
#define MK_REP_CONV 1
#endif
constexpr int NPHASES = 12;
struct Args { const float* in[22]; float* out; unsigned char* ws; int ph_lo, ph_hi; };
__global__ void __launch_bounds__(NWAVES * 64, 2) mk_fwd(Args args) {
    extern __shared__ __attribute__((aligned(16))) unsigned char lds_raw[];
    Frame F;
    F.lds = (LAS unsigned char*)lds_raw;
    F.MISC = (volatile LAS unsigned*)(F.lds + MISC_OFF);
    F.wave = __builtin_amdgcn_readfirstlane((int)threadIdx.x >> 6);
    F.G = gridDim.x; { const int bx = blockIdx.x; F.vcu = (F.G % 8 == 0) ? (bx % 8) * (F.G / 8) + bx / 8 : bx; }
    unsigned char* ws = args.ws; F.ws = ws; F.out = args.out;
#pragma unroll
    for (int i = 0; i < 22; ++i) F.in[i] = args.in[i];
    F.ctl = (gu32*)(ws + WS_CTL);
    for (int u = threadIdx.x; u < 1024 / 4; u += NWAVES * 64) ((LAS unsigned*)(F.lds + LDSCTL_OFF))[u] = 0u;
    __syncthreads();
    const int lo = args.ph_lo, hi = args.ph_hi;
    XcdBarrier bar; bar.bar = (unsigned*)(F.ctl + CW_BAR); bar.x = 0; bar.st = nullptr;
    if (hi - lo > 1) bar = xcd_barrier_post((unsigned*)(F.ctl + CW_BAR), F.MISC + 8);
#define IN(k) (lo <= (k) && (k) < hi)
#define SEAM(k) do { if (IN(k) && IN((k) + 1)) xcd_barrier(bar); } while (0)
    float* rss = (float*)(ws + WS_RSS);
    bf16* XB = (bf16*)(ws + WS_XB);
    LAS unsigned char* xs = F.lds + XP_OFF + F.wave * 2304;

    if (IN(0)) { p0_prologue(F); SEAM(0); }
    if (IN(1)) {
        pg8::Gemm g{XB, (const bf16*)(ws + WS_W0IN), T, AB_IN, DM}; pg8::StaticOrder S; S.init(T, AB_IN, F.G, (int)blockIdx.x);
        pg8::EpiIn0 E{rss, (bf16*)(ws + WS_UV), (bf16*)(ws + WS_Q), (bf16*)(ws + WS_K), (bf16*)(ws + WS_V), F.in[7], F.in[8], (const float*)(ws + WS_ROPE), xs, (const pg8::DwTab*)(ws + WS_DWTAB)};
        pg8::gemm_phase<pg8::EpiIn0, pg8::StaticOrder, true, true>(F.lds + RING_OFF, g, S, E, F.wave);
        SEAM(1);
    }
    if (IN(2)) {
        att::attn_phase(F.lds, F.vcu, F.G, (const bf16*)(ws + WS_Q), (const bf16*)(ws + WS_K), (const bf16*)(ws + WS_V), (bf16*)(ws + WS_Q), (float*)(ws + WS_LSE), F.wave);
        SEAM(2);
    }
    if (IN(3)) {
        for (int rep = 0; rep < MK_REP_SG; ++rep) for (int u = F.vcu; u < T / 128; u += F.G) sg_unit(F, u);
        SEAM(3);
    }
    if (IN(4)) {
        pg8::Gemm g{(const bf16*)(ws + WS_AB), (const bf16*)(ws + WS_W0OUT), T, DM, DM}; pg8::StaticOrder S; S.init(T, DM, F.G, (int)blockIdx.x);
        pg8::EpiRes E{XB, nullptr, rss + T, xs};
        pg8::gemm_phase<pg8::EpiRes, pg8::StaticOrder, true, true>(F.lds + RING_OFF, g, S, E, F.wave);
        SEAM(4);
    }
    if (IN(5)) {
        pg8::Gemm g{XB, (const bf16*)(ws + WS_W0GU), T, GU_N, DM}; pg8::StaticOrder S; S.init(T, GU_N, F.G, (int)blockIdx.x);
        pg8::EpiGUT<true> E{rss + T, (bf16*)(ws + WS_ACT), DFF, xs, (const pg8::DwTab*)(ws + WS_DWTAB)};
        pg8::gemm_phase<pg8::EpiGUT<true>, pg8::StaticOrder, true, true>(F.lds + RING_OFF, g, S, E, F.wave);
        SEAM(5);
    }
    if (IN(6)) {
        pg8::Gemm g{(const bf16*)(ws + WS_ACT), (const bf16*)(ws + WS_W0D), T, DM, DFF}; pg8::StaticOrder S; S.init(T, DM, F.G, (int)blockIdx.x);
        pg8::EpiRes E{XB, nullptr, rss + 2 * T, xs};
        pg8::gemm_phase<pg8::EpiRes, pg8::StaticOrder, true, true>(F.lds + RING_OFF, g, S, E, F.wave);
        SEAM(6);
    }
    if (IN(7)) {
        pg8::Gemm g{XB, (const bf16*)(ws + WS_W1IN), T, CD_IN, DM}; pg8::StaticOrder S; S.init(T, CD_IN, F.G, (int)blockIdx.x);
        pg8::EpiIn1 E{rss + 2 * T, (bf16*)(ws + WS_P1), xs};
        pg8::gemm_phase<pg8::EpiIn1, pg8::StaticOrder, true, true>(F.lds + RING_OFF, g, S, E, F.wave);
        SEAM(7);
    }
    if (IN(8)) {
        for (int rep = 0; rep < MK_REP_CONV; ++rep) for (int u = F.vcu; u < T / 128; u += F.G) conv_pair(F, u);
        SEAM(8);
    }
    if (IN(9)) {
        pg8::Gemm g{(const bf16*)(ws + WS_CD), (const bf16*)(ws + WS_W1OUT), T, DM, DM}; pg8::StaticOrder S; S.init(T, DM, F.G, (int)blockIdx.x);
        pg8::EpiRes E{XB, nullptr, rss + 3 * T, xs};
        pg8::gemm_phase<pg8::EpiRes, pg8::StaticOrder, true, true>(F.lds + RING_OFF, g, S, E, F.wave);
        SEAM(9);
    }
    if (IN(10)) {
        pg8::Gemm g{XB, (const bf16*)(ws + WS_W1GU), T, GU_N, DM}; pg8::StaticOrder S; S.init(T, GU_N, F.G, (int)blockIdx.x);
        pg8::EpiGUT<false> E{rss + 3 * T, (bf16*)(ws + WS_ACT), DFF, xs, nullptr};
        pg8::gemm_phase<pg8::EpiGUT<false>, pg8::StaticOrder, true, true>(F.lds + RING_OFF, g, S, E, F.wave);
        SEAM(10);
    }
    if (IN(11)) {
        pg8::Gemm g{(const bf16*)(ws + WS_ACT), (const bf16*)(ws + WS_W1D), T, DM, DFF}; pg8::StaticOrder S; S.init(T, DM, F.G, (int)blockIdx.x);
        pg8::EpiRes E{XB, F.out, nullptr, xs};
        pg8::gemm_phase<pg8::EpiRes, pg8::StaticOrder, true, true>(F.lds + RING_OFF, g, S, E, F.wave);
    }
#undef IN
#undef SEAM
}

#ifndef MK_PER_PHASE
#define MK_PER_PHASE 0
#endif
extern "C" void kernel_launch(void* const* d_in, const int* in_sizes, int n_in, void* d_out, int out_size, void* d_ws, size_t ws_size, hipStream_t stream) {
    static int grid = 0;
    if (grid == 0) {
        if (n_in != 22 || in_sizes[0] != T * DM || out_size != T * DM || ws_size < WS_END) { fprintf(stderr, "kernel_launch: unexpected shapes: n_in %d in0 %d out %d ws %zu (need %zu); nothing launched\n", n_in, n_in > 0 ? in_sizes[0] : -1, out_size, ws_size, (size_t)WS_END); grid = -1; return; }
        int dev = 0, cus = 0, per_cu = 0;
        if (hipGetDevice(&dev) != hipSuccess || hipDeviceGetAttribute(&cus, hipDeviceAttributeMultiprocessorCount, dev) != hipSuccess) { fprintf(stderr, "kernel_launch: device query failed\n"); grid = -1; return; }
        if (hipFuncSetAttribute((const void*)mk_fwd, hipFuncAttributeMaxDynamicSharedMemorySize, LDS_BYTES) != hipSuccess) { fprintf(stderr, "kernel_launch: hipFuncSetAttribute failed\n"); grid = -1; return; }
        if (hipOccupancyMaxActiveBlocksPerMultiprocessor(&per_cu, (const void*)mk_fwd, NWAVES * 64, LDS_BYTES) != hipSuccess || per_cu < 1) { fprintf(stderr, "kernel_launch: occupancy query says %d blocks per CU\n", per_cu); per_cu = 1; }
        (void)hipGetLastError();
        grid = cus;
        if (grid % 8 != 0 || grid > 256) grid = (grid / 8) * 8 > 256 ? 256 : (grid / 8) * 8;
    }
    if (grid <= 0) return;
    (void)hipMemsetAsync((char*)d_ws + WS_CTL, 0, CTL_ZERO_BYTES, stream);
    Args a{};
    for (int i = 0; i < 22; ++i) a.in[i] = (const float*)d_in[i];
    a.out = (float*)d_out; a.ws = (unsigned char*)d_ws;
#if MK_PER_PHASE
    for (int p = 0; p < NPHASES; ++p) { a.ph_lo = p; a.ph_hi = p + 1; hipLaunchKernelGGL(mk_fwd, dim3(grid), dim3(NWAVES * 64), LDS_BYTES, stream, a); }
#else
    a.ph_lo = 0; a.ph_hi = NPHASES;
    hipLaunchKernelGGL(mk_fwd, dim3(grid), dim3(NWAVES * 64), LDS_BYTES, stream, a);
#endif
    const hipError_t le = hipPeekAtLastError();
    if (le != hipSuccess) fprintf(stderr, "kernel_launch: launch failed: %s\n", hipGetErrorName(le));
}
```

```cpp
#include <hip/hip_runtime.h>
#include <cstdio>
#include <cstdint>
__device__ __forceinline__ int mk_lane_id() { return (int)__builtin_amdgcn_mbcnt_hi(~0u, __builtin_amdgcn_mbcnt_lo(~0u, 0u)); }
namespace pg8 {
#define PG8_LAS __attribute__((address_space(3)))
typedef unsigned short bf16_t;
typedef short bf16x8 __attribute__((ext_vector_type(8)));
typedef float f32x4 __attribute__((ext_vector_type(4)));
typedef unsigned u32x4 __attribute__((ext_vector_type(4)));
constexpr int BM = 256, BK = 64, HALF = 128, HTB = HALF * BK * 2  , STAGE_BYTES = 8 * HTB, NXCD = 8, WGM = 8;

__host__ __device__ __forceinline__ int lds_byte(int r, int c) { const int st = (r >> 4) * 2 + (c >> 5), rr = r & 15, cc = c & 31, ob = rr * 64 + cc * 2; return st * 1024 + (ob ^ (((ob >> 9) & 1) << 5)); }
__host__ __device__ __forceinline__ void stage_rc(int b, int& R, int& C) { const int st = b / 1024, sb = b % 1024, swz = sb ^ (((sb >> 9) & 1) << 5); R = (st >> 1) * 16 + swz / 64; C = (st & 1) * 32 + (swz % 64) / 2; }
__host__ __device__ __forceinline__ int perm32(int rho) { const int n = rho >> 4, i = rho & 15; return 8 * (i >> 2) + 4 * n + (i & 3); }

struct Unit { int pm, pn; };
struct Gemm { const bf16_t* A; const bf16_t* Bt; int M, N, K; };

struct StaticOrder {
    int nM, nN, nwg, G, c;
    __host__ __device__ void init(int M, int N, int G_, int c_) { nM = M / BM; nN = N / BM; nwg = nM * nN; G = G_; c = c_; }
    __host__ __device__ bool next(int i, Unit& u) const {
        const long L = (long)i * G + c; if (L >= nwg) return false;
        int wgid = (int)L; { const int q = nwg / NXCD, r = nwg % NXCD, xcd = wgid % NXCD, off = wgid / NXCD; wgid = (xcd < r ? xcd * (q + 1) : r * (q + 1) + (xcd - r) * q) + off; }
        const int nig = WGM * nN, gid = wgid / nig, fm = gid * WGM, gsz = (nM - fm) < WGM ? (nM - fm) : WGM;
        u.pm = fm + ((wgid % nig) % gsz); u.pn = (wgid % nig) / gsz; return true;
    }
    __device__ __forceinline__ void a_ready(const Unit&) const {}
    __device__ __forceinline__ void done(const Unit&) const {}
};

__device__ __forceinline__ unsigned cvt_pk_bf16(float lo, float hi) { unsigned r; asm volatile("v_cvt_pk_bf16_f32 %0, %1, %2" : "=v"(r) : "v"(lo), "v"(hi)); return r; }
typedef float f32x2 __attribute__((ext_vector_type(2)));
__device__ __forceinline__ f32x2 gelu_pk(f32x2 v) {
    const f32x2 av = __builtin_elementwise_abs(v), d = av * 0.2316418882f + 1.0f;
    f32x2 t; t.x = __builtin_amdgcn_rcpf(d.x); t.y = __builtin_amdgcn_rcpf(d.y);
    f32x2 q = t * 0.5307027145f + (-0.7265760135f); q = q * t + 0.7107068705f; q = q * t + (-0.142248368f); q = q * t + 0.127414796f; q = q * t;
    const f32x2 s = (v * v) * (-0.72134752044f);
    f32x2 e; e.x = __builtin_amdgcn_exp2f(s.x); e.y = __builtin_amdgcn_exp2f(s.y);
    const f32x2 m = v * (q * e), r = v - m;
    f32x2 o; o.x = v.x < 0.f ? m.x : r.x; o.y = v.y < 0.f ? m.y : r.y; return o;
}
template <class Epi, class Sched, bool ALIGN_EPI = false, bool SP2 = false>
__device__ __forceinline__ void gemm_phase(PG8_LAS unsigned char* lds, const Gemm g, const Sched& S, const Epi& E, const int wave_in) {
    int lane_ = mk_lane_id(); asm volatile("" : "+v"(lane_));
    const int lane = lane_, wid = wave_in, tid = wid * 64 + lane, wr = wid >> 2, wc = wid & 3, fr = lane & 15, fq = lane >> 4;
    const int K = g.K, nt = K / BK;
    unsigned voffA[2], voffB[2];
#pragma unroll
    for (int i = 0; i < 2; ++i) voffA[i] = voffB[i] = (unsigned)(tid * 16 + i * 8192);
    const size_t kstep = (size_t)(BM * BK * 2);
    const size_t hstep = (size_t)HALF * BK * 2;
    const size_t tstep = (size_t)(K / BK) * kstep;
    const unsigned ldsw = (unsigned)wid * 1024u;
    const int aoff = lds_byte(wr * 64 + fr, fq * 8), boff = lds_byte(wc * 32 + fr, fq * 8);
#define PG8_SA(b, h) (((b) * 2 + (h)) * HTB)
#define PG8_SB(b, h) ((4 + (b) * 2 + (h)) * HTB)
#define PG8_STAGE(bufoff, gbase, voff) do { _Pragma("unroll") for (int _i = 0; _i < 2; ++_i) \
        __builtin_amdgcn_global_load_lds((const unsigned*)((const char*)(gbase) + (voff)[_i]), (PG8_LAS unsigned*)(lds + (bufoff) + ldsw + _i * 8192), 16, 0, 0); } while (0)
#define PG8_LDA(dst, b, h) do { _Pragma("unroll") for (int m = 0; m < 4; ++m) _Pragma("unroll") for (int k = 0; k < 2; ++k) dst[m][k] = *(const PG8_LAS bf16x8*)(lds + PG8_SA(b, h) + aoff + m * 2048 + k * 1024); } while (0)
#define PG8_LDB(dst, b, h) do { _Pragma("unroll") for (int n = 0; n < 2; ++n) _Pragma("unroll") for (int k = 0; k < 2; ++k) dst[n][k] = *(const PG8_LAS bf16x8*)(lds + PG8_SB(b, h) + boff + n * 2048 + k * 1024); } while (0)
#define PG8_MMA(ai, bj, At, Bt) do { __builtin_amdgcn_s_setprio(1); _Pragma("unroll") for (int m = 0; m < 4; ++m) _Pragma("unroll") for (int n = 0; n < 2; ++n) _Pragma("unroll") for (int k = 0; k < 2; ++k) \
        acc[ai][bj][m][n] = __builtin_amdgcn_mfma_f32_16x16x32_bf16(Bt[n][k], At[m][k], acc[ai][bj][m][n], 0, 0, 0); __builtin_amdgcn_s_setprio(0); } while (0)
#define PG8_WAIT_V(n) asm volatile("s_waitcnt vmcnt(" #n ")" ::: "memory")
#define PG8_WAIT_L(n) asm volatile("s_waitcnt lgkmcnt(" #n ")" ::: "memory")
#define PG8_BAR __builtin_amdgcn_s_barrier()
#define PG8_SCHED __builtin_amdgcn_sched_barrier(0)
    Unit cur, nxt; int ui = 0;
    if (!S.next(0, cur)) return;
    f32x4 acc[2][2][4][2];
#pragma unroll
    for (int a = 0; a < 2; ++a)
#pragma unroll
        for (int b = 0; b < 2; ++b)
#pragma unroll
            for (int m = 0; m < 4; ++m)
#pragma unroll
                for (int n = 0; n < 2; ++n) acc[a][b][m][n] = (f32x4){0.f, 0.f, 0.f, 0.f};
    bf16x8 At[4][2], B0[2][2], B1[2][2];
    const char* cA = (const char*)g.A + (size_t)cur.pm * tstep; const char* cB = (const char*)g.Bt + (size_t)cur.pn * tstep;
    S.a_ready(cur);
    if constexpr (SP2) {
        PG8_STAGE(PG8_SB(0, 0), cB, voffB); PG8_STAGE(PG8_SB(0, 1), cB + hstep, voffB); PG8_STAGE(PG8_SA(0, 0), cA, voffA); PG8_STAGE(PG8_SA(0, 1), cA + hstep, voffA);
        if (wr == 1) PG8_BAR;
        PG8_WAIT_V(2); PG8_BAR;
        PG8_STAGE(PG8_SB(1, 0), cB + kstep, voffB); PG8_STAGE(PG8_SA(1, 0), cA + kstep, voffA); PG8_STAGE(PG8_SB(1, 1), cB + hstep + kstep, voffB);
        PG8_WAIT_V(6); PG8_BAR;
    } else {
        PG8_STAGE(PG8_SB(0, 0), cB, voffB); PG8_STAGE(PG8_SA(0, 0), cA, voffA); PG8_STAGE(PG8_SB(0, 1), cB + hstep, voffB); PG8_STAGE(PG8_SA(0, 1), cA + hstep, voffA);
        if (wr == 1) PG8_BAR;
        PG8_WAIT_V(4); PG8_BAR;
        PG8_STAGE(PG8_SB(1, 0), cB + kstep, voffB); PG8_STAGE(PG8_SA(1, 0), cA + kstep, voffA); PG8_STAGE(PG8_SB(1, 1), cB + hstep + kstep, voffB);
        PG8_WAIT_V(6); PG8_BAR;
    }
    for (;;) {
        const bool has_next = S.next(ui + 1, nxt);
        const char* nA = has_next ? (const char*)g.A + (size_t)nxt.pm * tstep : cA; const char* nB = has_next ? (const char*)g.Bt + (size_t)nxt.pn * tstep : cB;
        for (int t = 0; t < nt; t += 2) {
            const bool last = (t == nt - 2);
            const char* a1 = cA + (size_t)(t + 1) * kstep;
            const char* a2 = last ? nA : cA + (size_t)(t + 2) * kstep; const char* b2 = last ? nB : cB + (size_t)(t + 2) * kstep;
            const char* a3 = a2 + kstep; const char* b3 = b2 + kstep;
            if (last) E.prefetch(cur, wr, fq * 16 + fr);
            if (last && has_next) S.a_ready(nxt);
            if constexpr (SP2) {
            PG8_LDB(B0, 0, 0); PG8_LDB(B1, 0, 1); PG8_SCHED; PG8_LDA(At, 0, 0); PG8_STAGE(PG8_SA(1, 1), a1 + hstep, voffA);
            PG8_WAIT_V(8); PG8_WAIT_L(0); PG8_BAR; PG8_MMA(0, 0, At, B0); PG8_MMA(0, 1, At, B1); PG8_BAR; PG8_SCHED;
            PG8_LDA(At, 0, 1); PG8_STAGE(PG8_SB(0, 0), b2, voffB); PG8_STAGE(PG8_SB(0, 1), b2 + hstep, voffB); PG8_STAGE(PG8_SA(0, 0), a2, voffA);
            PG8_WAIT_V(8); PG8_WAIT_L(0); PG8_BAR; PG8_MMA(1, 0, At, B0); PG8_MMA(1, 1, At, B1); PG8_BAR; PG8_SCHED;
            PG8_LDB(B0, 1, 0); PG8_LDB(B1, 1, 1); PG8_SCHED; PG8_LDA(At, 1, 0); PG8_STAGE(PG8_SA(0, 1), a2 + hstep, voffA);
            PG8_WAIT_V(8); PG8_WAIT_L(0); PG8_BAR; PG8_MMA(0, 0, At, B0); PG8_MMA(0, 1, At, B1); PG8_BAR; PG8_SCHED;
            PG8_LDA(At, 1, 1); PG8_STAGE(PG8_SB(1, 0), b3, voffB); PG8_STAGE(PG8_SB(1, 1), b3 + hstep, voffB); PG8_STAGE(PG8_SA(1, 0), a3, voffA);
            PG8_WAIT_V(8); PG8_WAIT_L(0); PG8_BAR; PG8_MMA(1, 0, At, B0); PG8_MMA(1, 1, At, B1); PG8_BAR; PG8_SCHED;
            } else {
            PG8_LDB(B0, 0, 0); PG8_SCHED; PG8_LDA(At, 0, 0); PG8_STAGE(PG8_SA(1, 1), a1 + hstep, voffA);
            PG8_WAIT_L(8); PG8_BAR; PG8_WAIT_L(0); PG8_MMA(0, 0, At, B0); PG8_BAR; PG8_SCHED;
            PG8_LDB(B1, 0, 1); PG8_STAGE(PG8_SB(0, 0), b2, voffB);
            PG8_BAR; PG8_WAIT_L(0); PG8_MMA(0, 1, At, B1); PG8_BAR;
            PG8_LDA(At, 0, 1); PG8_STAGE(PG8_SA(0, 0), a2, voffA);
            PG8_BAR; PG8_WAIT_L(0); PG8_MMA(1, 0, At, B0); PG8_BAR; PG8_SCHED;
            PG8_STAGE(PG8_SB(0, 1), b2 + hstep, voffB);
            PG8_WAIT_V(6); PG8_BAR; PG8_MMA(1, 1, At, B1); PG8_BAR;
            PG8_LDB(B0, 1, 0); PG8_SCHED; PG8_LDA(At, 1, 0); PG8_STAGE(PG8_SA(0, 1), a2 + hstep, voffA);
            PG8_WAIT_L(8); PG8_BAR; PG8_WAIT_L(0); PG8_MMA(0, 0, At, B0); PG8_BAR; PG8_SCHED;
            PG8_LDB(B1, 1, 1); PG8_STAGE(PG8_SB(1, 0), b3, voffB);
            PG8_BAR; PG8_WAIT_L(0); PG8_MMA(0, 1, At, B1); PG8_BAR;
            PG8_LDA(At, 1, 1); PG8_STAGE(PG8_SA(1, 0), a3, voffA);
            PG8_BAR; PG8_WAIT_L(0); PG8_MMA(1, 0, At, B0); PG8_BAR; PG8_SCHED;
            PG8_STAGE(PG8_SB(1, 1), b3 + hstep, voffB);
            PG8_WAIT_V(6); PG8_BAR; PG8_MMA(1, 1, At, B1); PG8_BAR;
            }
        }
        if constexpr (ALIGN_EPI) { if (wr == 0) PG8_BAR; }
        if constexpr (!Epi::AFTER_DRAIN) { E(acc, cur, wr, wc, fr, fq); S.done(cur); }
        if (!has_next) break;
#pragma unroll
        for (int a = 0; a < 2; ++a)
#pragma unroll
            for (int b = 0; b < 2; ++b)
#pragma unroll
                for (int m = 0; m < 4; ++m)
#pragma unroll
                    for (int n = 0; n < 2; ++n) acc[a][b][m][n] = (f32x4){0.f, 0.f, 0.f, 0.f};
        cur = nxt; cA = nA; cB = nB; ++ui;
        if constexpr (ALIGN_EPI) { if (wr == 1) PG8_BAR; }
    }
    PG8_WAIT_V(0);
    if constexpr (!ALIGN_EPI) { if (wr == 0) PG8_BAR; }
    PG8_BAR;
    if constexpr (Epi::AFTER_DRAIN) { E.fused(acc, cur, wr, wc, fr, fq, lds, wid, lane); S.done(cur); }
#undef PG8_SA
#undef PG8_SB
#undef PG8_STAGE
#undef PG8_LDA
#undef PG8_LDB
#undef PG8_MMA
#undef PG8_WAIT_V
#undef PG8_WAIT_L
#undef PG8_BAR
#undef PG8_SCHED
}
}
namespace pg8 {
constexpr float NORM_EPS = 1e-6f;
typedef unsigned u32x2 __attribute__((ext_vector_type(2)));
__device__ __forceinline__ float sigmoid_f(float x) { return __builtin_amdgcn_rcpf(1.0f + __builtin_amdgcn_exp2f(-1.4426950408889634f * x)); }
__device__ __forceinline__ unsigned cvt2(float lo, float hi) { typedef float f2_t __attribute__((ext_vector_type(2))); typedef __bf16 b2_t __attribute__((ext_vector_type(2))); f2_t v = {lo, hi}; b2_t b = __builtin_convertvector(v, b2_t); return __builtin_bit_cast(unsigned, b); }
__device__ __forceinline__ u32x4 pack8(const f32x4 a, const f32x4 b) { u32x4 w; w.x = cvt2(a[0], a[1]); w.y = cvt2(a[2], a[3]); w.z = cvt2(b[0], b[1]); w.w = cvt2(b[2], b[3]); return w; }
__device__ __forceinline__ float dot4(const f32x4 a) { return (a[0] * a[0] + a[1] * a[1]) + (a[2] * a[2] + a[3] * a[3]); }

constexpr int XP_PITCH2 = 144, XP_PITCH1 = 80, XP_WAVE = 16 * XP_PITCH2;
__host__ __device__ __forceinline__ size_t kt_off(int row, int col, int ktiles) { return ((size_t)((row >> 8) * ktiles + (col >> 6)) * 256 + (row & 255)) * 64 + (col & 63); }
__host__ __device__ __forceinline__ size_t img_off(int row, int col, int ktiles) { return (((size_t)((row >> 8) * ktiles + (col >> 6)) * 2 + ((row >> 7) & 1)) * 16384 + lds_byte(row & 127, col & 63)) >> 1; }
__host__ __device__ __forceinline__ int invperm32(int j) { return 16 * ((j >> 2) & 1) + 4 * (j >> 3) + (j & 3); }
__host__ __device__ __forceinline__ size_t hm_off(int g, int b, int h, int t) { const int sh = 2 * g; return ((size_t)((((g * 8 + b) * 8 + h) << 12) + ((t & ((1 << sh) - 1)) << (12 - sh)) + (t >> sh))) * 64; }
__device__ __forceinline__ void xp_store2(PG8_LAS unsigned char* xs, int fr, int fq, const u32x4 w0, const u32x4 w1, bf16_t* base, int ld) {
    const int lane = fq * 16 + fr;
    *(PG8_LAS u32x4*)(xs + fr * XP_PITCH2 + fq * 16) = w0; *(PG8_LAS u32x4*)(xs + fr * XP_PITCH2 + 64 + fq * 16) = w1;
    const u32x4 a = *(const PG8_LAS u32x4*)(xs + (lane >> 3) * XP_PITCH2 + (lane & 7) * 16), b = *(const PG8_LAS u32x4*)(xs + ((lane >> 3) + 8) * XP_PITCH2 + (lane & 7) * 16);
    __builtin_nontemporal_store(a, (u32x4*)(base + (size_t)(lane >> 3) * ld + (lane & 7) * 8)); __builtin_nontemporal_store(b, (u32x4*)(base + (size_t)((lane >> 3) + 8) * ld + (lane & 7) * 8));
}
__device__ __forceinline__ void xp_put2(PG8_LAS unsigned char* xs, int fr, int fq, const u32x4 w0, const u32x4 w1, u32x4& a, u32x4& b) {
    const int lane = fq * 16 + fr;
    *(PG8_LAS u32x4*)(xs + fr * XP_PITCH2 + fq * 16) = w0; *(PG8_LAS u32x4*)(xs + fr * XP_PITCH2 + 64 + fq * 16) = w1;
    a = *(const PG8_LAS u32x4*)(xs + (lane >> 3) * XP_PITCH2 + (lane & 7) * 16); b = *(const PG8_LAS u32x4*)(xs + ((lane >> 3) + 8) * XP_PITCH2 + (lane & 7) * 16);
}
__device__ __forceinline__ void xp_put1(PG8_LAS unsigned char* xs, int fr, int fq, const u32x4 w0, u32x4& a) {
    const int lane = fq * 16 + fr;
    *(PG8_LAS u32x4*)(xs + fr * XP_PITCH1 + fq * 16) = w0;
    a = *(const PG8_LAS u32x4*)(xs + (lane >> 2) * XP_PITCH1 + (lane & 3) * 16);
}
__device__ __forceinline__ void nt16(const u32x4 v, bf16_t* p) { __builtin_nontemporal_store(v, (u32x4*)p); }
__device__ __forceinline__ f32x4 bf4_lo(unsigned a, unsigned b) { return (f32x4){__builtin_bit_cast(float, a << 16), __builtin_bit_cast(float, a & 0xffff0000u), __builtin_bit_cast(float, b << 16), __builtin_bit_cast(float, b & 0xffff0000u)}; }
struct EpiRes {
    static constexpr bool PERM = true, AFTER_DRAIN = false;
    __device__ __forceinline__ void prefetch(const Unit&, int, int) const {}
    bf16_t* xb; float* outf; float* rowss; PG8_LAS unsigned char* xs;
    __device__ __forceinline__ void operator()(const f32x4 (&acc)[2][2][4][2], const Unit& u, int wr, int wc, int fr, int fq) const {
        const int lane = fq * 16 + fr, rowg = u.pm * BM + wr * 64, colw = u.pn * BM + wc * 64;
        const int ob = fr * 64 + fq * 16, sw = ob ^ (((ob >> 9) & 1) << 5);
        bf16_t* const xw = xb + img_off(rowg, colw, 16) + (sw >> 1);
        u32x4 ga[8], gb[8];
#pragma unroll
        for (int i = 0; i < 8; ++i) { const bf16_t* g0 = xw + (i >> 2) * 8192 + (i & 3) * 1024; ga[i] = *(const u32x4*)g0; gb[i] = *(const u32x4*)(g0 + 512); }
#pragma unroll
        for (int ai = 0; ai < 2; ++ai)
#pragma unroll
            for (int m = 0; m < 4; ++m) {
                const int i = ai * 4 + m, row = rowg + ai * HALF + m * 16; const u32x4 r0 = ga[i], r1 = gb[i];
                const f32x4 v00 = acc[ai][0][m][0] + bf4_lo(r0.x, r0.y), v01 = acc[ai][0][m][1] + bf4_lo(r0.z, r0.w), v10 = acc[ai][1][m][0] + bf4_lo(r1.x, r1.y), v11 = acc[ai][1][m][1] + bf4_lo(r1.z, r1.w);
                if (outf) { float* o = outf + (size_t)row * 1024 + colw;
#pragma unroll
                    for (int bj = 0; bj < 2; ++bj) { const f32x4 x0 = bj ? v10 : v00, x1 = bj ? v11 : v01;
                        *(PG8_LAS f32x4*)(xs + fr * XP_PITCH2 + fq * 32) = x0; *(PG8_LAS f32x4*)(xs + fr * XP_PITCH2 + fq * 32 + 16) = x1;
                        const f32x4 a = *(const PG8_LAS f32x4*)(xs + (lane >> 3) * XP_PITCH2 + (lane & 7) * 16), b = *(const PG8_LAS f32x4*)(xs + ((lane >> 3) + 8) * XP_PITCH2 + (lane & 7) * 16);
                        __builtin_nontemporal_store(a, (f32x4*)(o + (size_t)(lane >> 3) * 1024 + bj * 32 + (lane & 7) * 4)); __builtin_nontemporal_store(b, (f32x4*)(o + (size_t)((lane >> 3) + 8) * 1024 + bj * 32 + (lane & 7) * 4)); } }
                else { bf16_t* g0 = xw + ai * 8192 + m * 1024; nt16(pack8(v00, v01), g0); nt16(pack8(v10, v11), g0 + 512); }
                if (rowss) { float ss = (dot4(v00) + dot4(v01)) + (dot4(v10) + dot4(v11)); ss += __shfl_xor(ss, 16); ss += __shfl_xor(ss, 32); if (fq == 0) atomicAdd(rowss + row + fr, ss); }
            }
    }
};

__device__ __forceinline__ void rs_prefetch(const float* rowss, int rowblk, int lane, PG8_LAS unsigned char* xs) {
    const float* src = rowss + rowblk + lane;
    __builtin_amdgcn_global_load_lds((const unsigned*)src, (PG8_LAS unsigned*)xs, 4, 0, 0);
    __builtin_amdgcn_global_load_lds((const unsigned*)(src + HALF), (PG8_LAS unsigned*)(xs + 256), 4, 0, 0);
}
__device__ __forceinline__ float rs_raw(const PG8_LAS unsigned char* xs, int i, int fr) { return ((const PG8_LAS float*)xs)[(i >> 2) * 64 + (i & 3) * 16 + fr]; }
__device__ __forceinline__ void load_rstd(float (&rs)[8], const float* rowss, int row0) {
#pragma unroll
    for (int i = 0; i < 8; ++i) rs[i] = rowss[row0 + (i >> 2) * HALF + (i & 3) * 16];
#pragma unroll
    for (int i = 0; i < 8; ++i) rs[i] = __builtin_amdgcn_rsqf(rs[i] * (1.0f / 1024.0f) + NORM_EPS);
}

__device__ __forceinline__ int dw_perm256(int n) { const int o = n & 255; return (n & ~255) + ((o >> 5) & 1) * 128 + (o >> 6) * 32 + (o & 31); }
__device__ __forceinline__ int dw_drow(int kind, int n) {
    if (kind == 2) return 256 * (n >> 7) + (n & 127);
    if (kind == 3) { if (n < 512) return 256 * (n >> 7) + (n & 127);
        if (n < 1024) { const int n1 = n - 512; return 256 * (n1 >> 7) + 128 + (n1 & 127); }
        if (n < 1536) return dw_perm256(n);
        if (n < 2048) { const int n1 = n - 1536; return 1536 + 256 * (n1 >> 7) + (n1 & 127); }
        const int n1 = n - 2048; return 1536 + 256 * (n1 >> 7) + 128 + (n1 & 127); }
    return dw_perm256(n);
}
constexpr int DW_NMAT = 6, DW_HALF_ITEMS = 2 * (1408 + 1280 + 512 + 1408 + 1408 + 1408);
struct DwTab { const float* W; const float* gain; bf16_t* WT; const void* pad; };
struct DwItem { const float* src; const float* gain; bf16_t* WT; int K, N, kind, radd, k0, n0; };
typedef unsigned u32x8s __attribute__((ext_vector_type(8)));
__device__ __forceinline__ void dw_desc(const DwTab* t, const float*& W, const float*& gain, bf16_t*& WT) {
    const unsigned long long a = (unsigned long long)t; const unsigned lo = __builtin_amdgcn_readfirstlane((unsigned)a), hi = __builtin_amdgcn_readfirstlane((unsigned)(a >> 32));
    const unsigned long long au = ((unsigned long long)hi << 32) | lo; u32x8s r;
    asm volatile("s_load_dwordx8 %0, %1, 0x0\n\ts_waitcnt lgkmcnt(0)" : "=s"(r) : "s"(au) : "memory");
    W = (const float*)(((unsigned long long)r[1] << 32) | r[0]); gain = (const float*)(((unsigned long long)r[3] << 32) | r[2]); WT = (bf16_t*)(((unsigned long long)r[5] << 32) | r[4]);
}
__device__ __forceinline__ DwItem dw_decode(const DwTab* tab, int did) {
    const int h = did & 1; int r = did >> 1, m;
    if (r < 1408) m = 0; else if ((r -= 1408) < 1280) m = 1; else if ((r -= 1280) < 512) m = 2; else if ((r -= 512) < 1408) m = 3; else if ((r -= 1408) < 1408) m = 4; else { r -= 1408; m = 5; }
    DwItem it; it.K = (m == 0 || m == 5) ? 2816 : 1024; it.N = m == 1 ? 2560 : ((m == 3 || m == 4) ? 2816 : 1024); it.kind = m == 1 ? 3 : ((m == 3 || m == 4) ? 2 : 0); it.radd = m == 4 ? 128 : 0;
    int kb, nb;
    if (m == 1) { kb = r / 40; nb = r - 40 * kb; } else if (m == 3 || m == 4) { kb = r / 44; nb = r - 44 * kb; } else { kb = r >> 4; nb = r & 15; }
    it.k0 = 32 * kb + 16 * h; it.n0 = 64 * nb; dw_desc(tab + m, it.src, it.gain, it.WT); return it;
}
__device__ __forceinline__ void dw_load(const DwItem& it, int lane, f32x4 (&wv)[4], float (&wg)[4]) {
    const int n4 = (lane & 15) * 4, kr = lane >> 4;
#pragma unroll
    for (int i = 0; i < 4; ++i) { const int k = it.k0 + 4 * kr + i; wv[i] = __builtin_nontemporal_load((const __attribute__((address_space(1))) f32x4*)(it.src + (size_t)k * it.N + it.n0 + n4)); wg[i] = ((const __attribute__((address_space(1))) float*)it.gain)[k]; }
}
__device__ __forceinline__ void dw_finish(const DwItem& it, int lane, const f32x4 (&wv)[4], const float (&wg)[4], PG8_LAS unsigned char* scr, bool on) {
    const int n4 = (lane & 15) * 4, kr = lane >> 4;
    const f32x4 x0 = wv[0] * wg[0], x1 = wv[1] * wg[1], x2 = wv[2] * wg[2], x3 = wv[3] * wg[3];
#pragma unroll
    for (int c = 0; c < 4; ++c) { u32x2 w; w.x = cvt2(x0[c], x1[c]); w.y = cvt2(x2[c], x3[c]); *(PG8_LAS u32x2*)(scr + (n4 + c) * 32 + kr * 8) = w; }
    asm volatile("" ::: "memory");
    const int kc = lane & 1, nr = lane >> 1;
#pragma unroll
    for (int j = 0; j < 2; ++j) { const int n = nr + 32 * j; const u32x4 o = *(const PG8_LAS u32x4*)(scr + n * 32 + kc * 16);
        const int nd = dw_drow(it.kind, it.n0 + n) + it.radd;
        if (on) *(__attribute__((address_space(1))) u32x4*)(it.WT + img_off((nd & ~31) + invperm32(nd & 31), it.k0 + 8 * kc, it.K >> 6)) = o; }
    asm volatile("" ::: "memory");
}

template <bool DW> struct EpiGUT {
    static constexpr bool PERM = true, AFTER_DRAIN = false;
    __device__ __forceinline__ void prefetch(const Unit& u, int wr, int lane) const { rs_prefetch(rowss, u.pm * BM + wr * 64, lane, xs); }
    const float* rowss; bf16_t* act; int ldc; PG8_LAS unsigned char* xs; const DwTab* dwtab;
    __device__ __forceinline__ void operator()(const f32x4 (&acc)[2][2][4][2], const Unit& u, int wr, int wc, int fr, int fq) const {
        const int lane = fq * 16 + fr, rowg = u.pm * BM + wr * 64, colw = u.pn * HALF + wc * 32;
        const int did = (u.pm * 22 + u.pn) * 8 + wr * 4 + wc; const bool dw = DW && did < DW_HALF_ITEMS;
        DwItem dit; f32x4 wv[4]; float wg[4];
        if constexpr (DW) { dit = dw_decode(dwtab, dw ? did : 0); dw_load(dit, lane, wv, wg); }
        asm volatile("" ::: "memory");
        float msv[8], rsv[8];
#pragma unroll
        for (int i = 0; i < 8; ++i) msv[i] = rs_raw(xs, i, fr) * (1.0f / 1024.0f) + NORM_EPS;
#pragma unroll
        for (int i = 0; i < 8; ++i) rsv[i] = __builtin_amdgcn_rsqf(msv[i]);
        const int ob = fr * 64 + fq * 16, sw = ob ^ (((ob >> 9) & 1) << 5);
        bf16_t* const tile = act + img_off(rowg, colw, ldc >> 6) + (sw >> 1);
#pragma unroll
        for (int ai = 0; ai < 2; ++ai)
#pragma unroll
            for (int m = 0; m < 4; ++m) {
                const int i = ai * 4 + m; const float rs = rsv[i];
                f32x4 o[2]; const float kq = -1.4426950408889634f * rs; const f32x2 ms = {msv[i], msv[i]};
#pragma unroll
                for (int n = 0; n < 2; ++n) { const f32x4 g4 = acc[ai][0][m][n], u4 = acc[ai][1][m][n];
#pragma unroll
                    for (int h = 0; h < 2; ++h) { const f32x2 g = {g4[2 * h], g4[2 * h + 1]}, u = {u4[2 * h], u4[2 * h + 1]};
                        const f32x2 p = g * u, t = g * kq; f32x2 e; e.x = __builtin_amdgcn_exp2f(t.x); e.y = __builtin_amdgcn_exp2f(t.y);
                        const f32x2 d = __builtin_elementwise_fma(e, ms, ms); f32x2 r; r.x = __builtin_amdgcn_rcpf(d.x); r.y = __builtin_amdgcn_rcpf(d.y);
                        const f32x2 q = p * r; o[n][2 * h] = q.x; o[n][2 * h + 1] = q.y; } }
                nt16(pack8(o[0], o[1]), tile + ai * 8192 + m * 1024);
            }
        if constexpr (DW) dw_finish(dit, lane, wv, wg, xs, dw);
    }
};

__device__ __forceinline__ float xchg16(float x) { const unsigned xb = __builtin_bit_cast(unsigned, x); const auto r = __builtin_amdgcn_permlane16_swap(xb, xb, false, false); const unsigned r0 = r[0], r1 = r[1];
    return __builtin_bit_cast(float, r0 ^ r1 ^ xb); }
__device__ __forceinline__ float sum16(float x) { const unsigned xb = __builtin_bit_cast(unsigned, x); const auto r = __builtin_amdgcn_permlane16_swap(xb, xb, false, false); const unsigned r0 = r[0], r1 = r[1];
    return __builtin_bit_cast(float, r0) + __builtin_bit_cast(float, r1); }
__device__ __forceinline__ float sum32(float x) { const unsigned xb = __builtin_bit_cast(unsigned, x); const auto r = __builtin_amdgcn_permlane32_swap(xb, xb, false, false); const unsigned r0 = r[0], r1 = r[1];
    return __builtin_bit_cast(float, r0) + __builtin_bit_cast(float, r1); }
struct EpiIn0 {
    static constexpr bool PERM = true, AFTER_DRAIN = false;
    __device__ __forceinline__ void prefetch(const Unit& u, int wr, int lane) const { rs_prefetch(rowss, u.pm * BM + wr * 64, lane, xs); }
    const float* rowss; bf16_t* UV; bf16_t* Qb; bf16_t* Kb; bf16_t* Vb; const float* qg; const float* kg; const float* rope; PG8_LAS unsigned char* xs;
    __device__ __forceinline__ void operator()(const f32x4 (&acc)[2][2][4][2], const Unit& u, int wr, int wc, int fr_, int fq_) const {
        int lane = fq_ * 16 + fr_; asm volatile("" : "+v"(lane)); const int fr = lane & 15, fq = lane >> 4;
        const int rowg = u.pm * BM + wr * 64, row0 = rowg + fr, pn = u.pn;
        float rsv[8];
#pragma unroll
        for (int i = 0; i < 8; ++i) rsv[i] = __builtin_amdgcn_rsqf(rs_raw(xs, i, fr) * (1.0f / 1024.0f) + NORM_EPS);
        asm volatile("" ::: "memory");
        u32x4 pa, pb;
        if (pn < 4) {
            bf16_t* const tile = UV + kt_off(rowg, pn * BM + wc * 64, 16) + (size_t)(lane >> 3) * 64 + (lane & 7) * 8;
#pragma unroll
            for (int ai = 0; ai < 2; ++ai)
#pragma unroll
                for (int m = 0; m < 4; ++m) {
                    const int i = ai * 4 + m; const float rs = rsv[i]; u32x4 w[2];
#pragma unroll
                    for (int bj = 0; bj < 2; ++bj) { f32x4 v0 = acc[ai][bj][m][0] * rs, v1 = acc[ai][bj][m][1] * rs;
                        const f32x2 a = gelu_pk((f32x2){v0[0], v0[1]}), b = gelu_pk((f32x2){v0[2], v0[3]}), c = gelu_pk((f32x2){v1[0], v1[1]}), d = gelu_pk((f32x2){v1[2], v1[3]});
                        v0 = (f32x4){a.x, a.y, b.x, b.y}; v1 = (f32x4){c.x, c.y, d.x, d.y}; w[bj] = pack8(v0, v1); }
                    if (i > 0) { bf16_t* t0 = tile + (size_t)(((i - 1) >> 2) * HALF + ((i - 1) & 3) * 16) * 64; nt16(pa, t0); nt16(pb, t0 + 8 * 64); }
                    xp_put2(xs, fr, fq, w[0], w[1], pa, pb);
                }
            { bf16_t* t0 = tile + (size_t)(HALF + 3 * 16) * 64; nt16(pa, t0); nt16(pb, t0 + 8 * 64); }
        } else if (pn < 16) {
            const int t = pn - 4, isk = t >= 6 ? 1 : 0, tt = t - 6 * isk, g = tt >> 1, head = 4 * (tt & 1) + wc;
            const int Ra = rowg + (lane >> 3), Rb = Ra + 8, sh = 2 * g;
            bf16_t* const pA = (isk ? Kb : Qb) + hm_off(g, Ra >> 12, head, Ra & 4095) + (lane & 7) * 8; bf16_t* const pB = (isk ? Kb : Qb) + hm_off(g, Rb >> 12, head, Rb & 4095) + (lane & 7) * 8;
            const float osc = isk ? 1.0f : 0.125f * 1.4426950408889634f;
            const float* gp = (isk ? kg : qg) + g * 64 + 8 * fq;
            const f32x4 g00 = *(const f32x4*)(gp) * osc, g01 = *(const f32x4*)(gp + 4) * osc, g10 = *(const f32x4*)(gp + 32) * osc, g11 = *(const f32x4*)(gp + 36) * osc;
            u32x4 rq[4][2];
            const unsigned flip = fq == 0 ? 0x80000000u : 0u;
#pragma unroll
            for (int i = 0; i < 4; ++i) { const int rown = row0 + i * 16; const unsigned* rp = (const unsigned*)rope + (size_t)(fq < 2 ? (rown & 4095) : 4096) * 8; rq[i][0] = *(const u32x4*)(rp); rq[i][1] = *(const u32x4*)(rp + 4); }
            float scv[8]; u32x4 oa[8], ob[8];
#pragma unroll
            for (int i = 0; i < 8; ++i) { const f32x4 a0 = acc[i >> 2][0][i & 3][0], a1 = acc[i >> 2][0][i & 3][1], b0 = acc[i >> 2][1][i & 3][0], b1 = acc[i >> 2][1][i & 3][1];
                f32x2 p = (f32x2){a0[0], a0[1]} * (f32x2){a0[0], a0[1]};
                p = __builtin_elementwise_fma((f32x2){a0[2], a0[3]}, (f32x2){a0[2], a0[3]}, p); p = __builtin_elementwise_fma((f32x2){a1[0], a1[1]}, (f32x2){a1[0], a1[1]}, p); p = __builtin_elementwise_fma((f32x2){a1[2], a1[3]}, (f32x2){a1[2], a1[3]}, p);
                p = __builtin_elementwise_fma((f32x2){b0[0], b0[1]}, (f32x2){b0[0], b0[1]}, p); p = __builtin_elementwise_fma((f32x2){b0[2], b0[3]}, (f32x2){b0[2], b0[3]}, p);
                p = __builtin_elementwise_fma((f32x2){b1[0], b1[1]}, (f32x2){b1[0], b1[1]}, p); p = __builtin_elementwise_fma((f32x2){b1[2], b1[3]}, (f32x2){b1[2], b1[3]}, p);
                scv[i] = p.x + p.y; }
#pragma unroll
            for (int i = 0; i < 8; ++i) scv[i] = sum32(sum16(scv[i]));
#pragma unroll
            for (int i = 0; i < 8; ++i) scv[i] = rsv[i] * __builtin_amdgcn_rsqf(scv[i] * (rsv[i] * rsv[i]) * (1.0f / 64.0f) + NORM_EPS);
#pragma unroll
            for (int ai = 0; ai < 2; ++ai)
#pragma unroll
                for (int m = 0; m < 4; ++m) {
                    const int i = ai * 4 + m;
                    f32x4 a0 = acc[ai][0][m][0], a1 = acc[ai][0][m][1], b0 = acc[ai][1][m][0], b1 = acc[ai][1][m][1];
                    const float sc = scv[i];
                    a0 = a0 * sc * g00; a1 = a1 * sc * g01; b0 = b0 * sc * g10; b1 = b1 * sc * g11;
                    const u32x4 r0 = rq[i & 3][0], r1 = rq[i & 3][1];
                    const unsigned rw[8] = {r0.x, r0.y, r0.z, r0.w, r1.x, r1.y, r1.z, r1.w};
                    const float mine[8] = {a0[0], a0[1], a0[2], a0[3], a1[0], a1[1], a1[2], a1[3]}; f32x2 rot[4];
#pragma unroll
                    for (int e = 0; e < 8; e += 2) { const f32x2 cs = {__builtin_bit_cast(float, rw[e] << 16), __builtin_bit_cast(float, rw[e + 1] << 16)};
                        const f32x2 sn = {__builtin_bit_cast(float, (rw[e] & 0xffff0000u) ^ flip), __builtin_bit_cast(float, (rw[e + 1] & 0xffff0000u) ^ flip)};
                        const f32x2 oth = {xchg16(mine[e]), xchg16(mine[e + 1])}, me = {mine[e], mine[e + 1]};
                        rot[e >> 1] = __builtin_elementwise_fma(oth, sn, me * cs); }
                    a0 = (f32x4){rot[0].x, rot[0].y, rot[1].x, rot[1].y}; a1 = (f32x4){rot[2].x, rot[2].y, rot[3].x, rot[3].y};
                    if (i < 4) { const int rown = row0 + HALF + i * 16; const unsigned* rp = (const unsigned*)rope + (size_t)(fq < 2 ? (rown & 4095) : 4096) * 8; rq[i][0] = *(const u32x4*)(rp); rq[i][1] = *(const u32x4*)(rp + 4); }
                    if (i >= 4 && i < 7) {
#pragma unroll
                        for (int j = 2 * (i - 4); j < 2 * (i - 4) + 2; ++j) { const size_t go = (size_t)((((j >> 2) * HALF + (j & 3) * 16) >> sh) * 64); nt16(oa[j], pA + go); nt16(ob[j], pB + go); } }
                    if (i == 7) { const size_t go = (size_t)(((HALF + 2 * 16) >> sh) * 64); nt16(oa[6], pA + go); nt16(ob[6], pB + go); }
                    xp_put2(xs, fr, fq, pack8(a0, a1), pack8(b0, b1), oa[i], ob[i]);
                }
            { const size_t go = (size_t)(((HALF + 3 * 16) >> sh) * 64); nt16(oa[7], pA + go); nt16(ob[7], pB + go); }
        } else {
            const int g = (pn - 16) >> 1, head = 4 * ((pn - 16) & 1) + wc;
            const int Ra = rowg + (lane >> 3), Rb = Ra + 8, sh = 2 * g;
            bf16_t* const pA = Vb + hm_off(g, Ra >> 12, head, Ra & 4095) + (lane & 7) * 8; bf16_t* const pB = Vb + hm_off(g, Rb >> 12, head, Rb & 4095) + (lane & 7) * 8;
#pragma unroll
            for (int ai = 0; ai < 2; ++ai)
#pragma unroll
                for (int m = 0; m < 4; ++m) {
                    const int i = ai * 4 + m; const float rs = rsv[i];
                    if (i > 0) { const size_t go = (size_t)(((((i - 1) >> 2) * HALF + ((i - 1) & 3) * 16) >> sh) * 64); nt16(pa, pA + go); nt16(pb, pB + go); }
                    xp_put2(xs, fr, fq, pack8(acc[ai][0][m][0] * rs, acc[ai][0][m][1] * rs), pack8(acc[ai][1][m][0] * rs, acc[ai][1][m][1] * rs), pa, pb);
                }
            { const size_t go = (size_t)(((HALF + 3 * 16) >> sh) * 64); nt16(pa, pA + go); nt16(pb, pB + go); }
        }
    }
};

struct EpiIn1 {
    static constexpr bool PERM = true, AFTER_DRAIN = false;
    __device__ __forceinline__ void prefetch(const Unit& u, int wr, int lane) const { rs_prefetch(rowss, u.pm * BM + wr * 64, lane, xs); }
    const float* rowss; bf16_t* P1; PG8_LAS unsigned char* xs;
    __device__ __forceinline__ void operator()(const f32x4 (&acc)[2][2][4][2], const Unit& u, int wr, int wc, int fr, int fq) const {
        const int lane = fq * 16 + fr, rowg = u.pm * BM + wr * 64, pn = u.pn;
        float rsv[8];
#pragma unroll
        for (int i = 0; i < 8; ++i) rsv[i] = __builtin_amdgcn_rsqf(rs_raw(xs, i, fr) * (1.0f / 1024.0f) + NORM_EPS);
        asm volatile("" ::: "memory");
        u32x4 pa, pb;
        if (pn >= 4 && pn < 6) {
            bf16_t* const tile = P1 + kt_off(rowg, 512 + (pn - 4) * BM + wc * 64, 24) + (size_t)(lane >> 3) * 64 + (lane & 7) * 8;
#pragma unroll
            for (int ai = 0; ai < 2; ++ai)
#pragma unroll
                for (int m = 0; m < 4; ++m) {
                    const int i = ai * 4 + m; const float rs = rsv[i];
                    if (i > 0) { bf16_t* t0 = tile + (size_t)(((i - 1) >> 2) * HALF + ((i - 1) & 3) * 16) * 64; nt16(pa, t0); nt16(pb, t0 + 8 * 64); }
                    xp_put2(xs, fr, fq, pack8(acc[ai][0][m][0] * rs, acc[ai][0][m][1] * rs), pack8(acc[ai][1][m][0] * rs, acc[ai][1][m][1] * rs), pa, pb);
                }
            { bf16_t* t0 = tile + (size_t)(HALF + 3 * 16) * 64; nt16(pa, t0); nt16(pb, t0 + 8 * 64); }
        } else {
            const int col = (pn < 4 ? pn * HALF : 1024 + (pn - 6) * HALF) + wc * 32;
            bf16_t* const tile = P1 + kt_off(rowg, col, 24) + (size_t)(lane >> 2) * 64 + (lane & 3) * 8;
#pragma unroll
            for (int ai = 0; ai < 2; ++ai)
#pragma unroll
                for (int m = 0; m < 4; ++m) {
                    const int i = ai * 4 + m; const float rs = rsv[i]; f32x4 o[2];
                    if (pn < 4) {
#pragma unroll
                        for (int n = 0; n < 2; ++n) { const f32x4 a4 = acc[ai][0][m][n], g4 = acc[ai][1][m][n]; const float kq = -1.4426950408889634f * rs, irs1 = __builtin_amdgcn_rcpf(rs); const f32x2 irs = {irs1, irs1};
#pragma unroll
                            for (int h = 0; h < 2; ++h) { const f32x2 a = {a4[2 * h], a4[2 * h + 1]}, g = {g4[2 * h], g4[2 * h + 1]};
                                const f32x2 t = g * kq; f32x2 e; e.x = __builtin_amdgcn_exp2f(t.x); e.y = __builtin_amdgcn_exp2f(t.y);
                                const f32x2 d = __builtin_elementwise_fma(e, irs, irs); f32x2 r; r.x = __builtin_amdgcn_rcpf(d.x); r.y = __builtin_amdgcn_rcpf(d.y);
                                const f32x2 q = a * r; o[n][2 * h] = q.x; o[n][2 * h + 1] = q.y; } }
                    } else {
#pragma unroll
                        for (int n = 0; n < 2; ++n) o[n] = (acc[ai][0][m][n] * rs) * (acc[ai][1][m][n] * rs); }
                    if (i > 0) nt16(pa, tile + (size_t)(((i - 1) >> 2) * HALF + ((i - 1) & 3) * 16) * 64);
                    xp_put1(xs, fr, fq, pack8(o[0], o[1]), pa);
                }
            nt16(pa, tile + (size_t)(HALF + 3 * 16) * 64);
        }
    }
};

}

constexpr int NWAVES = 8;
constexpr int BATCH = 8, SEQ = 4096, DM = 1024, T = BATCH * SEQ;
constexpr int AB_IN = 5632, CD_IN = 2560, DFF = 2816, GU_N = 2 * DFF;
constexpr size_t MiB = 1u << 20;
constexpr size_t WS_CTL = 0, CTL_ZERO_BYTES = 32 * 1024;
constexpr size_t WS_ROPE = 1 * MiB;
constexpr size_t WS_DWTAB = WS_ROPE + 192 * 1024;
constexpr size_t WS_WSG = WS_ROPE + 256 * 1024;
constexpr size_t WS_RSS = WS_WSG + 128 * 1024;
constexpr size_t WS_LSE = 2 * MiB;
constexpr size_t WS_W0IN = 8 * MiB;
constexpr size_t WS_W0OUT = 19 * MiB;
constexpr size_t WS_W0GU = 21 * MiB;
constexpr size_t WS_W0D = 32 * MiB;
constexpr size_t WS_W1IN = 38 * MiB;
constexpr size_t WS_W1OUT = 43 * MiB;
constexpr size_t WS_W1GU = 45 * MiB;
constexpr size_t WS_W1D = 56 * MiB;
constexpr size_t WS_XB = 64 * MiB;
constexpr size_t WS_UV = 128 * MiB;
constexpr size_t WS_Q = 192 * MiB;
constexpr size_t WS_K = 288 * MiB;
constexpr size_t WS_V = 384 * MiB;
constexpr size_t WS_ACT = WS_Q;
constexpr size_t WS_P1 = 368 * MiB;
constexpr size_t WS_AB = WS_K, WS_CD = WS_UV;
constexpr size_t WS_END = 480 * MiB;
constexpr int CW_BAR = 4096;

constexpr int RING_OFF = 0, RING_BYTES = 131072;
constexpr int LDSCTL_OFF = RING_BYTES, MISC_OFF = LDSCTL_OFF + 320;
constexpr int AUX_OFF = LDSCTL_OFF + 1024;
constexpr int XP_OFF = AUX_OFF + 2048;
constexpr int LDS_BYTES = 155648;
static_assert(XP_OFF + 8 * 2304 <= LDS_BYTES, "LDS map");
#define GAS __attribute__((address_space(1)))
#define LAS __attribute__((address_space(3)))
typedef unsigned short bf16;
typedef unsigned v4u __attribute__((ext_vector_type(4)));
typedef float f32x4 __attribute__((ext_vector_type(4)));
typedef short bf16x8 __attribute__((ext_vector_type(8)));
typedef GAS unsigned gu32;
typedef GAS unsigned long long gu64;
#define RLX_AGENT __ATOMIC_RELAXED, __HIP_MEMORY_SCOPE_AGENT
#define LDS_WAIT() asm volatile("s_waitcnt lgkmcnt(0)" ::: "memory")
#define VM_WAIT() asm volatile("s_waitcnt vmcnt(0)" ::: "memory")
__device__ __forceinline__ unsigned long long rt() { return __builtin_amdgcn_s_memrealtime(); }
__device__ __forceinline__ unsigned f2bf(float f) { unsigned u = __builtin_bit_cast(unsigned, f); return (u + 0x7fffu + ((u >> 16) & 1u)) >> 16; }
__device__ __forceinline__ unsigned pk2(float lo, float hi) { return f2bf(lo) | (f2bf(hi) << 16); }

#define XB_TMO      128
#define XB_XCNT(j)  (256  + 64 * (j))
#define XB_XSUB(j)  (1280 + 64 * (j))
#define XB_XGEN(j)  (2304 + 64 * (j))
#define XB_TOP      3328
#define XB_TOPGEN   3392
#define XCD_BAR_WORDS 3456
#define XB_SPIN_CAP (1u << 18)

__device__ __forceinline__ unsigned xb_ld(unsigned* p)              { return __hip_atomic_load(p, __ATOMIC_RELAXED, __HIP_MEMORY_SCOPE_AGENT); }
__device__ __forceinline__ unsigned xb_add(unsigned* p, unsigned v) { return __hip_atomic_fetch_add(p, v, __ATOMIC_RELAXED, __HIP_MEMORY_SCOPE_AGENT); }
__device__ __forceinline__ unsigned xb_xcc_id() { return (unsigned)__builtin_amdgcn_s_getreg((3 << 11) | 20) & 0xFu; }
#define XB_SPIN(cond, bar) do { unsigned _sp = 0; while (cond) { __builtin_amdgcn_s_sleep(1); \
    if ((++_sp & 255u) == 0u) { if (xb_ld(&(bar)[XB_TMO])) break; if (_sp > XB_SPIN_CAP) { atomicAdd(&(bar)[XB_TMO], 1u); break; } } } } while (0)

struct XcdBarrier {
    unsigned* bar; unsigned x;
    volatile LAS unsigned* st;
};

__device__ __forceinline__ XcdBarrier xcd_barrier_post(unsigned* bar, volatile LAS unsigned* st) {
    XcdBarrier b; b.bar = bar; b.x = xb_xcc_id(); b.st = st;
    if (threadIdx.x == 0) (void)xb_add(&bar[XB_XCNT(b.x)], 1u);
    return b;
}
__device__ __forceinline__ void xcd_barrier_complete(unsigned* bar, unsigned x, unsigned& nloc, unsigned& nx) {
    const unsigned G = gridDim.x * gridDim.y * gridDim.z;
    unsigned sum, cnt, mine, sp = 0u;
    for (;;) {
        sum = 0u; cnt = 0u; mine = 0u;
#pragma unroll
        for (unsigned j = 0; j < 16; ++j) { const unsigned c = xb_ld(&bar[XB_XCNT(j)]); sum += c; cnt += (c > 0u) ? 1u : 0u; mine = (j == x) ? c : mine; }
        if (sum == G) break;
        __builtin_amdgcn_s_sleep(1);
        if ((++sp & 255u) == 0u) { if (xb_ld(&bar[XB_TMO])) break; if (sp > XB_SPIN_CAP) { atomicAdd(&bar[XB_TMO], 1u); break; } }
    }
    nloc = mine > 0u ? mine : 1u; nx = cnt > 0u ? cnt : 1u;
}

__device__ __forceinline__ void xcd_barrier(const XcdBarrier& b) {
    asm volatile("s_waitcnt vmcnt(0)" ::: "memory");
    __syncthreads();
    if (threadIdx.x == 0) {
        unsigned* bar = b.bar;
        __builtin_amdgcn_s_waitcnt(0);
        unsigned nloc = b.st[0], nx = b.st[1];
        if (nloc == 0u) { xcd_barrier_complete(bar, b.x, nloc, nx); b.st[0] = nloc; b.st[1] = nx; }
        const unsigned old = xb_add(&bar[XB_XSUB(b.x)], 1u);
        const unsigned gen = old / nloc;
        if (old + 1u == (gen + 1u) * nloc) {
            __builtin_amdgcn_fence(__ATOMIC_RELEASE, "agent");
            asm volatile("s_waitcnt vmcnt(0)" ::: "memory");
            const unsigned og = xb_add(&bar[XB_TOP], 1u);
            const unsigned tg = og / nx;
            if (og + 1u == (tg + 1u) * nx) xb_add(&bar[XB_TOPGEN], 1u);
            else XB_SPIN(xb_ld(&bar[XB_TOPGEN]) == tg, bar);
            __builtin_amdgcn_fence(__ATOMIC_ACQUIRE, "agent");
            xb_add(&bar[XB_XGEN(b.x)], 1u);
            asm volatile("s_waitcnt vmcnt(0)" ::: "memory");
        } else {
            XB_SPIN(xb_ld(&bar[XB_XGEN(b.x)]) == gen, bar);
            __builtin_amdgcn_fence(__ATOMIC_ACQUIRE, "agent");
            asm volatile("s_waitcnt vmcnt(0)" ::: "memory");
        }
    }
    __syncthreads();
}

typedef unsigned u32x2 __attribute__((ext_vector_type(2)));
typedef float f32x16 __attribute__((ext_vector_type(16)));
typedef short s16x4 __attribute__((ext_vector_type(4)));
struct Frame {
    LAS unsigned char* lds;
    volatile LAS unsigned* MISC;
    gu32* ctl;
    int wave;
    int vcu, G;
    const float* in[22];
    float* out;
    unsigned char* ws;
};
__device__ __forceinline__ float wave_sum(float v) {
#pragma unroll
    for (int o = 1; o < 64; o <<= 1) v += __shfl_xor(v, o);
    return v;
}
__device__ __forceinline__ int red16_idx(int lane) { return ((lane >> 5) & 1) * 8 + ((lane >> 4) & 1) * 4 + ((lane >> 3) & 1) * 2 + ((lane >> 2) & 1); }
template <int H, int MSK> __device__ __forceinline__ void red16_step(float (&v)[16], int lane) { const bool up = (lane & MSK) != 0;
#pragma unroll
    for (int i = 0; i < H; ++i) { const float send = up ? v[i] : v[i + H], keep = up ? v[i + H] : v[i]; v[i] = keep + __shfl_xor(send, MSK); } }
__device__ __forceinline__ void reduce16(float (&v)[16], int lane) {
    red16_step<8, 32>(v, lane); red16_step<4, 16>(v, lane); red16_step<2, 8>(v, lane); red16_step<1, 4>(v, lane);
    v[0] += __shfl_xor(v[0], 2); v[0] += __shfl_xor(v[0], 1);
}
__device__ __forceinline__ unsigned cvtpk_s(float lo, float hi) { typedef float f2_t __attribute__((ext_vector_type(2))); typedef __bf16 b2_t __attribute__((ext_vector_type(2)));
    f2_t v = {lo, hi}; b2_t b = __builtin_convertvector(v, b2_t); return __builtin_bit_cast(unsigned, b); }
__device__ __forceinline__ float bf_lo(unsigned w) { return __builtin_bit_cast(float, w << 16); }
__device__ __forceinline__ float bf_hi(unsigned w) { return __builtin_bit_cast(float, w & 0xffff0000u); }

__device__ __forceinline__ int p0_perm256(int n) { const int o = n & 255; return (n & ~255) + ((o >> 5) & 1) * 128 + (o >> 6) * 32 + (o & 31); }
__device__ __forceinline__ int p0_drow(int kind, int n) {
    if (kind == 2) return 256 * (n >> 7) + (n & 127);
    if (kind == 3) { if (n < 512) return 256 * (n >> 7) + (n & 127);
        if (n < 1024) { const int n1 = n - 512; return 256 * (n1 >> 7) + 128 + (n1 & 127); }
        if (n < 1536) return p0_perm256(n);
        if (n < 2048) { const int n1 = n - 1536; return 1536 + 256 * (n1 >> 7) + (n1 & 127); }
        const int n1 = n - 2048; return 1536 + 256 * (n1 >> 7) + 128 + (n1 & 127); }
    return p0_perm256(n);
}
__device__ __forceinline__ void p0_item(const float* W, int K, int N, int k0, int n0, bf16* WT, int kind, int radd, const float* gain, LAS unsigned char* scr, int lane) {
    const int n4 = (lane & 15) * 4, kr = lane >> 4;
    f32x4 v[16]; float gv[16];
#pragma unroll
    for (int i = 0; i < 16; ++i) { v[i] = __builtin_nontemporal_load((const GAS f32x4*)(W + (size_t)(k0 + 4 * i + kr) * N + n0 + n4)); gv[i] = gain ? gain[k0 + 4 * i + kr] : 1.0f; }
#pragma unroll
    for (int i = 0; i < 16; ++i) { const f32x4 x = v[i] * gv[i]; LAS unsigned* d = (LAS unsigned*)(scr + (4 * i + kr) * 132 + n4 * 2); d[0] = pk2(x.x, x.y); d[1] = pk2(x.z, x.w); }
    LDS_WAIT(); asm volatile("" ::: "memory");
    const int kc = lane & 7, nr = lane >> 3;
#pragma unroll
    for (int j = 0; j < 8; ++j) { const int n = nr + 8 * j; const LAS unsigned short* sp = (const LAS unsigned short*)(scr + (8 * kc) * 132 + n * 2);
        v4u o; o.x = (unsigned)sp[0] | ((unsigned)sp[66] << 16); o.y = (unsigned)sp[132] | ((unsigned)sp[198] << 16); o.z = (unsigned)sp[264] | ((unsigned)sp[330] << 16); o.w = (unsigned)sp[396] | ((unsigned)sp[462] << 16);
        const int nd = p0_drow(kind, n0 + n) + radd;
        *(GAS v4u*)(WT + pg8::img_off((nd & ~31) + pg8::invperm32(nd & 31), k0 + 8 * kc, K >> 6)) = o; }
    LDS_WAIT(); asm volatile("" ::: "memory");
}
__device__ __forceinline__ void p0_prologue(Frame& F) {
    LAS unsigned char* scr = F.lds + RING_OFF + F.wave * 16384;
    const int lane = mk_lane_id(); const int gw = F.vcu * NWAVES + F.wave, NGW = F.G * NWAVES;
    unsigned char* ws = F.ws;
    constexpr int I_IN0 = 16 * (AB_IN / 64), I_SQ = 16 * 16, I_GU = 16 * (DFF / 64), I_DN = (DFF / 64) * 16, I_IN1 = 16 * (CD_IN / 64);
    constexpr int NITEMS = I_IN0 + I_SQ + 2 * I_GU;
    for (int it = gw; it < NITEMS; it += NGW) {
        int r = it;
        if (r < I_IN0) { const int nblk = AB_IN / 64; p0_item(F.in[2], 1024, AB_IN, 64 * (r / nblk), 64 * (r % nblk), (bf16*)(ws + WS_W0IN), 1, 0, F.in[1], scr, lane); continue; }
        r -= I_IN0;
        if (r < I_SQ) { p0_item(F.in[9], 1024, 1024, 64 * (r / 16), 64 * (r % 16), (bf16*)(ws + WS_W0OUT), 0, 0, nullptr, scr, lane); continue; }
        r -= I_SQ;
        if (r < 2 * I_GU) { const int up = r >= I_GU ? 1 : 0; r -= up * I_GU; const int nblk = DFF / 64;
            p0_item(F.in[up ? 20 : 19], 1024, DFF, 64 * (r / nblk), 64 * (r % nblk), (bf16*)(ws + WS_W0GU), 2, 128 * up, F.in[18], scr, lane); continue; }
    }
    if (gw == 0 && lane == 0) {
        pg8::DwTab* tab = (pg8::DwTab*)(ws + WS_DWTAB); const float* ones = (const float*)(ws + WS_DWTAB + 4096);
        tab[0] = pg8::DwTab{F.in[21], ones, (bf16*)(ws + WS_W0D), nullptr};
        tab[1] = pg8::DwTab{F.in[11], F.in[10], (bf16*)(ws + WS_W1IN), nullptr};
        tab[2] = pg8::DwTab{F.in[17], ones, (bf16*)(ws + WS_W1OUT), nullptr};
        tab[3] = pg8::DwTab{F.in[19] + (size_t)1024 * DFF, F.in[18] + 1024, (bf16*)(ws + WS_W1GU), nullptr};
        tab[4] = pg8::DwTab{F.in[20] + (size_t)1024 * DFF, F.in[18] + 1024, (bf16*)(ws + WS_W1GU), nullptr};
        tab[5] = pg8::DwTab{F.in[21] + (size_t)DFF * 1024, ones, (bf16*)(ws + WS_W1D), nullptr};
    }
    float* rss = (float*)(ws + WS_RSS); bf16* XB = (bf16*)(ws + WS_XB);
    for (int m0 = gw * 16; m0 < T; m0 += NGW * 16) {
        const int fr = lane & 15, fq = lane >> 4, ob = fr * 64 + fq * 16, sw = ob ^ (((ob >> 9) & 1) << 5);
        const GAS f32x4* xr = (const GAS f32x4*)(F.in[0] + (size_t)(m0 + fr) * DM + fq * 8);
        bf16* const xo = XB + pg8::img_off(m0, 0, 16) + (sw >> 1);
        float ss = 0.f;
#pragma unroll
        for (int cb = 0; cb < 4; ++cb) {
            f32x4 v[8][2];
#pragma unroll
            for (int c = 0; c < 8; ++c) { v[c][0] = __builtin_nontemporal_load(xr + (cb * 8 + c) * 8); v[c][1] = __builtin_nontemporal_load(xr + (cb * 8 + c) * 8 + 1); }
#pragma unroll
            for (int c = 0; c < 8; ++c) { const f32x4 a = v[c][0], b2 = v[c][1]; const int cg = cb * 8 + c;
                ss += ((a.x * a.x + a.y * a.y) + (a.z * a.z + a.w * a.w)) + ((b2.x * b2.x + b2.y * b2.y) + (b2.z * b2.z + b2.w * b2.w));
                v4u o; o.x = pk2(a.x, a.y); o.y = pk2(a.z, a.w); o.z = pk2(b2.x, b2.y); o.w = pk2(b2.z, b2.w);
                *(GAS v4u*)(xo + (cg >> 1) * 16384 + (cg & 1) * 512) = o; }
        }
        ss += __shfl_xor(ss, 16); ss += __shfl_xor(ss, 32);
        if (fq == 0) rss[m0 + fr] = ss;
    }
    const int gt = gw * 64 + lane, NGT = NGW * 64;
    for (int i = gt; i < DFF; i += NGT) ((float*)(ws + WS_DWTAB + 4096))[i] = 1.0f;
    for (int i = gt; i < 3 * T; i += NGT) rss[T + i] = 0.f;
    float* rope = (float*)(ws + WS_ROPE);
    for (int i = gt; i < SEQ * 8 + 8; i += NGT) { const int pos = i >> 3, k = i & 7; const float inv = exp2f(-2.3664460711655218f * (float)k), ang = (float)pos * inv;
        ((unsigned*)rope)[i] = pos < SEQ ? pk2(cosf(ang), sinf(ang)) : 0x00003f80u; }
    bf16* wsg = (bf16*)(ws + WS_WSG); const float* sw = F.in[5];
    for (int i = gt; i < 4 * 128 * 128; i += NGT) { const int g = i >> 14, t = (i >> 7) & 127, s = i & 127;
        wsg[((((g * 4 + (t >> 5)) * 8 + (s >> 4)) * 64 + ((s >> 3) & 1) * 32 + (t & 31)) << 3) + (s & 7)] = (bf16)(s <= t ? f2bf(sw[i]) : 0u); }
}

namespace att {
constexpr int KCH = 6160, LDS_KO = 0, LDS_VO = 8 * KCH, NUNITS = 3 * BATCH * 8 * 16;
__device__ __forceinline__ s16x4 vtr(const LAS unsigned char* p) { return __builtin_bit_cast(s16x4, __builtin_amdgcn_ds_read_tr16_b64_v4i16((LAS s16x4*)p)); }
struct UnitAddr { int g, h, sh, qb, rowb, j0; size_t hb; };
__device__ __forceinline__ UnitAddr decode(int U) { UnitAddr a; a.g = U >> 10; const int rem = U & 1023, b = rem >> 7, cq = rem & 15; a.h = (rem >> 4) & 7;
    a.sh = 2 * a.g; const int nbs = 4 - a.sh, c = cq >> nbs; a.qb = cq & ((1 << nbs) - 1); a.j0 = 256 * a.qb - 128; a.rowb = b * SEQ + c; a.hb = ((size_t)((((a.g * 8 + b) * 8 + a.h) << 12) + (c << (12 - a.sh)))) * 64; return a; }
__device__ __forceinline__ void attn_load(int U, bool chained, const bf16* Qb, const bf16* Kb, const bf16* Vb, v4u (&kv)[6], v4u (&vv)[6], bf16x8 (&qr)[4], int tid, int wid, int lane) {
    const UnitAddr a = decode(U);
#pragma unroll
    for (int i = 0; i < 6; ++i) { const int idx = i * 512 + tid, key = idx >> 3, ch = idx & 7, j = a.j0 + key;
        kv[i] = (v4u){0u, 0u, 0u, 0u}; vv[i] = (v4u){0u, 0u, 0u, 0u};
        if (j >= 0 && !(chained && i < 2)) {
            const size_t off = a.hb + (size_t)j * 64 + ch * 8; kv[i] = __builtin_nontemporal_load((const GAS v4u*)(Kb + off)); vv[i] = __builtin_nontemporal_load((const GAS v4u*)(Vb + off)); } }
    const size_t qoff = a.hb + (size_t)(256 * a.qb + 32 * wid + (lane >> 3)) * 64 + (lane & 7) * 8;
#pragma unroll
    for (int k = 0; k < 4; ++k) qr[k] = __builtin_nontemporal_load((const GAS bf16x8*)(Qb + qoff + (size_t)k * 8 * 64));
}
__device__ __forceinline__ LAS unsigned char* wave_scr(LAS unsigned char* lds, int wid) { return lds + (wid < 7 ? LDS_VO + 49152 + wid * 4096 : XP_OFF); }
__device__ __forceinline__ void q_frags(LAS unsigned char* scr, const bf16x8 (&qn)[4], bf16x8 (&qr)[4], int lane) {
    const int r32 = lane & 31, hi = lane >> 5;
#pragma unroll
    for (int k = 0; k < 4; ++k) { const int row = 8 * k + (lane >> 3); *(LAS bf16x8*)(scr + row * 128 + (((lane & 7) ^ (row & 7)) << 4)) = qn[k]; }
#pragma unroll
    for (int d0 = 0; d0 < 4; ++d0) qr[d0] = *(const LAS bf16x8*)(scr + r32 * 128 + (((2 * d0 + hi) ^ (r32 & 7)) << 4));
}
__device__ __forceinline__ void attn_stage(LAS unsigned char* lds, int qb, bool chained, const v4u (&kv)[6], const v4u (&vv)[6], int tid) {
    const int rb = (256 * qb) % 384;
#pragma unroll
    for (int i = 0; i < 6; ++i) { if (chained && i < 2) continue;
        const int idx = i * 512 + tid, ch = idx & 7; int key = rb + (idx >> 3); if (key >= 384) key -= 384;
        *(LAS v4u*)(lds + LDS_KO + ch * KCH + key * 16) = kv[i];
        *(LAS v4u*)(lds + LDS_VO + ((key >> 3) * 2 + (ch >> 2)) * 512 + (key & 7) * 64 + (ch & 3) * 16) = vv[i]; }
}
__device__ __forceinline__ void attn_compute(LAS unsigned char* lds, int U, const bf16x8 (&qr)[4], bf16* Ob, float* LSE, int wid, int lane) {
    const UnitAddr a = decode(U); const int qb = a.qb;
    const int r32 = lane & 31, hi = lane >> 5;
    const size_t qrow = (size_t)(a.rowb + ((256 * qb + 32 * wid + r32) << a.sh));
    const int tb0 = ((8 * qb) % 12 + wid) % 12;
    f32x16 p[5];
#pragma unroll
    for (int kt = 0; kt < 5; ++kt) {
        const int ts = (tb0 + kt >= 12) ? tb0 + kt - 12 : tb0 + kt;
        const LAS unsigned char* kp = lds + LDS_KO + hi * KCH + (32 * ts + r32) * 16;
        bf16x8 kf[4];
#pragma unroll
        for (int d0 = 0; d0 < 4; ++d0) kf[d0] = *(const LAS bf16x8*)(kp + d0 * 2 * KCH);
        f32x16 acc = {};
#pragma unroll
        for (int d0 = 0; d0 < 4; ++d0) acc = __builtin_amdgcn_mfma_f32_32x32x16_bf16(kf[d0], qr[d0], acc, 0, 0, 0);
        p[kt] = acc;
    }
#pragma unroll
    for (int kt = 0; kt < 4; ++kt) { const bool ex = (qb > 0) || (wid + kt >= 4);
#pragma unroll
        for (int r = 0; r < 16; ++r) p[kt][r] = ex ? p[kt][r] : -INFINITY; }
#pragma unroll
    for (int r = 0; r < 16; ++r) { const int cr = (r & 3) + 8 * (r >> 2) + 4 * hi; if (cr < r32) p[0][r] = -INFINITY; if (cr > r32) p[4][r] = -INFINITY; }
    float m4[4] = {-INFINITY, -INFINITY, -INFINITY, -INFINITY};
#pragma unroll
    for (int kt = 0; kt < 5; ++kt)
#pragma unroll
        for (int r = 0; r < 16; r += 8) {
#pragma unroll
            for (int c = 0; c < 4; ++c) m4[c] = fmaxf(m4[c], fmaxf(p[kt][r + 2 * c], p[kt][r + 2 * c + 1])); }
    float m = fmaxf(fmaxf(m4[0], m4[1]), fmaxf(m4[2], m4[3]));
    m = fmaxf(m, __shfl_xor(m, 32));
    float l4[4] = {0.f, 0.f, 0.f, 0.f};
#pragma unroll
    for (int kt = 0; kt < 5; ++kt)
#pragma unroll
        for (int r = 0; r < 16; ++r) { p[kt][r] = __builtin_amdgcn_exp2f(p[kt][r] - m); l4[r & 3] += p[kt][r]; }
    float l = (l4[0] + l4[1]) + (l4[2] + l4[3]);
    l += __shfl_xor(l, 32);
    f32x16 o0 = {}, o1 = {};
    const int gi = lane >> 4, q_ = (lane & 15) >> 2, p_ = lane & 3;
    const LAS unsigned char* vbase = lds + LDS_VO + (4 * hi + q_) * 64 + (gi & 1) * 32 + p_ * 8;
#pragma unroll
    for (int kt = 0; kt < 5; ++kt) {
        const bool ex = (qb > 0) || (wid + kt >= 4);
        const int ts = (tb0 + kt >= 12) ? tb0 + kt - 12 : tb0 + kt;
        if (ex) {
#pragma unroll
            for (int s = 0; s < 2; ++s) {
                v4u pw; pw.x = cvtpk_s(p[kt][8 * s + 0], p[kt][8 * s + 1]); pw.y = cvtpk_s(p[kt][8 * s + 2], p[kt][8 * s + 3]); pw.z = cvtpk_s(p[kt][8 * s + 4], p[kt][8 * s + 5]); pw.w = cvtpk_s(p[kt][8 * s + 6], p[kt][8 * s + 7]);
                const bf16x8 pb = __builtin_bit_cast(bf16x8, pw);
                const LAS unsigned char* vp = vbase + (4 * ts + 2 * s) * 1024;
                const s16x4 a00 = vtr(vp), a01 = vtr(vp + 1024), a10 = vtr(vp + 512), a11 = vtr(vp + 1536);
                const bf16x8 A0 = (bf16x8){a00[0], a00[1], a00[2], a00[3], a01[0], a01[1], a01[2], a01[3]}, A1 = (bf16x8){a10[0], a10[1], a10[2], a10[3], a11[0], a11[1], a11[2], a11[3]};
                o0 = __builtin_amdgcn_mfma_f32_32x32x16_bf16(A0, pb, o0, 0, 0, 0); o1 = __builtin_amdgcn_mfma_f32_32x32x16_bf16(A1, pb, o1, 0, 0, 0);
            }
        }
    }
    const float inv = 1.0f / l;
    LAS unsigned char* scr = wave_scr(lds, wid);
#pragma unroll
    for (int rg = 0; rg < 4; ++rg) {
        u32x2 w0, w1; w0.x = cvtpk_s(o0[4 * rg] * inv, o0[4 * rg + 1] * inv); w0.y = cvtpk_s(o0[4 * rg + 2] * inv, o0[4 * rg + 3] * inv);
        w1.x = cvtpk_s(o1[4 * rg] * inv, o1[4 * rg + 1] * inv); w1.y = cvtpk_s(o1[4 * rg + 2] * inv, o1[4 * rg + 3] * inv);
        *(LAS u32x2*)(scr + r32 * 128 + ((rg ^ (r32 & 7)) << 4) + 8 * hi) = w0; *(LAS u32x2*)(scr + r32 * 128 + (((4 + rg) ^ (r32 & 7)) << 4) + 8 * hi) = w1; }
    bf16* op = Ob + a.hb + (size_t)(256 * qb + 32 * wid + (lane >> 3)) * 64 + (lane & 7) * 8;
#pragma unroll
    for (int k = 0; k < 4; ++k) { const int row = 8 * k + (lane >> 3); const v4u v = *(const LAS v4u*)(scr + row * 128 + (((lane & 7) ^ (row & 7)) << 4)); *(GAS v4u*)(op + (size_t)k * 8 * 64) = v; }
    if (hi == 0) LSE[((size_t)a.g * T + qrow) * 8 + a.h] = m + __builtin_amdgcn_logf(l);
}
__device__ __forceinline__ void attn_phase(LAS unsigned char* lds, int vcu, int G, const bf16* Qb, const bf16* Kb, const bf16* Vb, bf16* Ob, float* LSE, int wid) {
    int lane = mk_lane_id(); asm volatile("" : "+v"(lane)); const int tid = wid * 64 + lane;
    v4u kv[6], vv[6]; bf16x8 qn[4], qr[4];
    if (G == 256) {
        attn_load(4 * vcu, false, Qb, Kb, Vb, kv, vv, qn, tid, wid, lane);
        for (int s = 0; s < 12; ++s) { const int U = (s >> 2) * 1024 + 4 * vcu + (s & 3); const bool chained = (s < 8) && ((s & 3) != 0);
            attn_stage(lds, decode(U).qb, chained, kv, vv, tid);
            q_frags(wave_scr(lds, wid), qn, qr, lane);
            __syncthreads();
            if (s + 1 < 12) { const int Un = ((s + 1) >> 2) * 1024 + 4 * vcu + ((s + 1) & 3); attn_load(Un, (s + 1 < 8) && (((s + 1) & 3) != 0), Qb, Kb, Vb, kv, vv, qn, tid, wid, lane); }
            attn_compute(lds, U, qr, Ob, LSE, wid, lane);
            __syncthreads();
        }
        return;
    }
    if (vcu >= NUNITS) return;
    attn_load(vcu, false, Qb, Kb, Vb, kv, vv, qn, tid, wid, lane);
    for (int U = vcu; U < NUNITS; U += G) {
        attn_stage(lds, decode(U).qb, false, kv, vv, tid);
        q_frags(wave_scr(lds, wid), qn, qr, lane);
        __syncthreads();
        if (U + G < NUNITS) attn_load(U + G, false, Qb, Kb, Vb, kv, vv, qn, tid, wid, lane);
        attn_compute(lds, U, qr, Ob, LSE, wid, lane);
        __syncthreads();
    }
}
}

__device__ __forceinline__ void sg_unit(Frame& F, int unit) {
    LAS unsigned char* lds = F.lds; int lane = mk_lane_id(); asm volatile("" : "+v"(lane)); const int wid = F.wave, tid = wid * 64 + lane;
    const int row0 = unit * 128;
    const bf16* UV = (const bf16*)(F.ws + WS_UV); bf16* AB = (bf16*)(F.ws + WS_AB); const bf16* OG = (const bf16*)(F.ws + WS_Q); const float* LSE = (const float*)(F.ws + WS_LSE);
    const bf16* wsg = (const bf16*)(F.ws + WS_WSG);
    v4u uu[16];
    LAS f32x4* wts = (LAS f32x4*)(lds + XP_OFF);
    {
        v4u raw[16]; float sm[16], sq[16];
#pragma unroll
        for (int tk = 0; tk < 16; ++tk) raw[tk] = __builtin_nontemporal_load((const GAS v4u*)(UV + pg8::kt_off(row0 + wid * 16 + tk, 512 + 8 * lane, 16)));
        float l0[2], l1[2], l2[2];
#pragma unroll
        for (int q = 0; q < 2; ++q) { const int pr = q * 512 + tid; const size_t row = (size_t)(row0 + (pr >> 3)); const int head = pr & 7;
            l0[q] = LSE[row * 8 + head]; l1[q] = LSE[((size_t)T + row) * 8 + head]; l2[q] = LSE[((size_t)2 * T + row) * 8 + head]; }
#pragma unroll
        for (int q = 0; q < 8; ++q) { const int idx = q * 512 + tid, t = idx >> 6, chunk = idx & 63; uu[q] = __builtin_nontemporal_load((const GAS v4u*)(UV + pg8::kt_off(row0 + t, chunk * 8, 16))); }
        const f32x4 ga = *(const f32x4*)(F.in[3] + 8 * lane), gb = *(const f32x4*)(F.in[3] + 8 * lane + 4), ba = *(const f32x4*)(F.in[4] + 8 * lane), bb = *(const f32x4*)(F.in[4] + 8 * lane + 4);
#pragma unroll
        for (int tk = 0; tk < 16; ++tk) { const float x0 = bf_lo(raw[tk].x), x1 = bf_hi(raw[tk].x), x2 = bf_lo(raw[tk].y), x3 = bf_hi(raw[tk].y), x4 = bf_lo(raw[tk].z), x5 = bf_hi(raw[tk].z), x6 = bf_lo(raw[tk].w), x7 = bf_hi(raw[tk].w);
            sm[tk] = ((x0 + x1) + (x2 + x3)) + ((x4 + x5) + (x6 + x7)); sq[tk] = ((x0 * x0 + x1 * x1) + (x2 * x2 + x3 * x3)) + ((x4 * x4 + x5 * x5) + (x6 * x6 + x7 * x7)); }
        reduce16(sm, lane); reduce16(sq, lane);
        LAS float* st = (LAS float*)(lds + AUX_OFF) + wid * 32;
        { const float mean = sm[0] * (1.0f / 512.0f), var = fmaxf(sq[0] * (1.0f / 512.0f) - mean * mean, 0.f);
          if ((lane & 3) == 0) { st[2 * red16_idx(lane)] = mean; st[2 * red16_idx(lane) + 1] = __builtin_amdgcn_rsqf(var + 1e-6f); } }
#pragma unroll
        for (int tk = 0; tk < 16; ++tk) { const int s = wid * 16 + tk; const float mean = st[2 * tk], rstd = st[2 * tk + 1];
            const float x0 = bf_lo(raw[tk].x) - mean, x1 = bf_hi(raw[tk].x) - mean, x2 = bf_lo(raw[tk].y) - mean, x3 = bf_hi(raw[tk].y) - mean, x4 = bf_lo(raw[tk].z) - mean, x5 = bf_hi(raw[tk].z) - mean, x6 = bf_lo(raw[tk].w) - mean, x7 = bf_hi(raw[tk].w) - mean;
            v4u o; o.x = cvtpk_s(x0 * rstd * ga[0] + ba[0], x1 * rstd * ga[1] + ba[1]); o.y = cvtpk_s(x2 * rstd * ga[2] + ba[2], x3 * rstd * ga[3] + ba[3]);
            o.z = cvtpk_s(x4 * rstd * gb[0] + bb[0], x5 * rstd * gb[1] + bb[1]); o.w = cvtpk_s(x6 * rstd * gb[2] + bb[2], x7 * rstd * gb[3] + bb[3]);
            *(LAS v4u*)(lds + ((s >> 3) * 16 + (lane >> 2)) * 512 + (s & 7) * 64 + (lane & 3) * 16) = o; }
#pragma unroll
        for (int q = 0; q < 2; ++q) { const int pr = q * 512 + tid;
            const float mx = fmaxf(l0[q], fmaxf(l1[q], l2[q])); const float w0 = __builtin_amdgcn_exp2f(l0[q] - mx), w1 = __builtin_amdgcn_exp2f(l1[q] - mx), w2 = __builtin_amdgcn_exp2f(l2[q] - mx);
            const float iv = 1.0f / (w0 + w1 + w2); wts[pr] = (f32x4){w0 * iv, w1 * iv, w2 * iv, 0.f}; }
    }
    __syncthreads();
    v4u ma[8], mb[8], mc[8];
#define SG_MLOAD(H, TID) _Pragma("unroll") for (int q = 0; q < 8; ++q) { const int idx = ((H) * 8 + q) * 512 + (TID), tk = idx >> 6, pc = idx & 63, head = pc >> 3; const size_t row = (size_t)(row0 + tk); \
        const int bb_ = (int)(row >> 12), tt_ = (int)(row & 4095), dd = (pc & 7) * 8; \
        ma[q] = __builtin_nontemporal_load((const GAS v4u*)(OG + pg8::hm_off(0, bb_, head, tt_) + dd)); mb[q] = __builtin_nontemporal_load((const GAS v4u*)(OG + pg8::hm_off(1, bb_, head, tt_) + dd)); \
        mc[q] = __builtin_nontemporal_load((const GAS v4u*)(OG + pg8::hm_off(2, bb_, head, tt_) + dd)); }
#define SG_MERGE(H, TID) _Pragma("unroll") for (int q = 0; q < 8; ++q) { const int idx = ((H) * 8 + q) * 512 + (TID), tk = idx >> 6, pc = idx & 63; const size_t row = (size_t)(row0 + tk); \
        const f32x4 w = wts[tk * 8 + (pc >> 3)]; const float w0 = w[0], w1 = w[1], w2 = w[2]; \
        v4u o; \
        o.x = cvtpk_s(w0 * bf_lo(ma[q].x) + w1 * bf_lo(mb[q].x) + w2 * bf_lo(mc[q].x), w0 * bf_hi(ma[q].x) + w1 * bf_hi(mb[q].x) + w2 * bf_hi(mc[q].x)); \
        o.y = cvtpk_s(w0 * bf_lo(ma[q].y) + w1 * bf_lo(mb[q].y) + w2 * bf_lo(mc[q].y), w0 * bf_hi(ma[q].y) + w1 * bf_hi(mb[q].y) + w2 * bf_hi(mc[q].y)); \
        o.z = cvtpk_s(w0 * bf_lo(ma[q].z) + w1 * bf_lo(mb[q].z) + w2 * bf_lo(mc[q].z), w0 * bf_hi(ma[q].z) + w1 * bf_hi(mb[q].z) + w2 * bf_hi(mc[q].z)); \
        o.w = cvtpk_s(w0 * bf_lo(ma[q].w) + w1 * bf_lo(mb[q].w) + w2 * bf_lo(mc[q].w), w0 * bf_hi(ma[q].w) + w1 * bf_hi(mb[q].w) + w2 * bf_hi(mc[q].w)); \
        *(GAS v4u*)(AB + pg8::img_off((int)row, 512 + pc * 8, 16)) = o; }
    {
        int lb_ = lane; asm volatile("" : "+v"(lb_));
        const int r32 = lb_ & 31, hi = lb_ >> 5, gi = lb_ >> 4, q_ = (lb_ & 15) >> 2, p_ = lb_ & 3;
        const int g = wid >> 1, ch0 = g * 128 + (wid & 1) * 64;
        f32x16 acc[2][4];
#pragma unroll
        for (int ct = 0; ct < 2; ++ct)
#pragma unroll
            for (int tt = 0; tt < 4; ++tt) acc[ct][tt] = (f32x16){};
        const LAS unsigned char* abase = lds + (hi * 16 + (ch0 >> 5)) * 512 + q_ * 64 + (gi & 1) * 32 + p_ * 8;
        const bf16* wb = wsg + ((size_t)(g * 4 * 8) * 64 + lb_) * 8;
#pragma unroll
        for (int ks = 0; ks < 8; ++ks) {
            bf16x8 A[2];
#pragma unroll
            for (int ct = 0; ct < 2; ++ct) { const s16x4 lo = att::vtr(abase + (2 * ks * 16 + ct) * 512), hh = att::vtr(abase + (2 * ks * 16 + ct) * 512 + 256);
                A[ct] = (bf16x8){lo[0], lo[1], lo[2], lo[3], hh[0], hh[1], hh[2], hh[3]}; }
#pragma unroll
            for (int tt = 0; tt < 4; ++tt) if (ks < 2 * (tt + 1)) {
                const bf16x8 B = *(const GAS bf16x8*)(wb + (size_t)((tt * 8 + ks) * 64) * 8);
#pragma unroll
                for (int ct = 0; ct < 2; ++ct) acc[ct][tt] = __builtin_amdgcn_mfma_f32_32x32x16_bf16(A[ct], B, acc[ct][tt], 0, 0, 0); }
        }
        const float* bias = F.in[6] + g * 128;
        __syncthreads();
#pragma unroll
        for (int tt = 0; tt < 4; ++tt) { const int t = 32 * tt + r32; const float bs = bias[t];
#pragma unroll
            for (int ct = 0; ct < 2; ++ct)
#pragma unroll
                for (int rg = 0; rg < 4; ++rg) { const int c = ch0 + 32 * ct + 8 * rg + 4 * hi;
                    u32x2 w; w.x = cvtpk_s(acc[ct][tt][4 * rg] + bs, acc[ct][tt][4 * rg + 1] + bs); w.y = cvtpk_s(acc[ct][tt][4 * rg + 2] + bs, acc[ct][tt][4 * rg + 3] + bs);
                    *(LAS u32x2*)(lds + t * 1024 + ((((c >> 3) ^ (t & 15)) << 4) | ((c & 4) << 1))) = w; } }
    }
    int lc_ = lane; asm volatile("" : "+v"(lc_)); const int tidc = wid * 64 + lc_;
#pragma unroll
    for (int q = 8; q < 16; ++q) { const int idx = q * 512 + tidc, t = idx >> 6, chunk = idx & 63; uu[q] = __builtin_nontemporal_load((const GAS v4u*)(UV + pg8::kt_off(row0 + t, chunk * 8, 16))); }
    SG_MLOAD(0, tidc)
    __syncthreads();
    int ld_ = lane; asm volatile("" : "+v"(ld_)); const int tidd = wid * 64 + ld_;
#pragma unroll
    for (int q = 0; q < 16; ++q) { const int idx = q * 512 + tidd, t = idx >> 6, chunk = idx & 63;
        const v4u m = *(const LAS v4u*)(lds + t * 1024 + ((chunk ^ (t & 15)) << 4)); v4u o;
        o.x = cvtpk_s(bf_lo(uu[q].x) * bf_lo(m.x), bf_hi(uu[q].x) * bf_hi(m.x)); o.y = cvtpk_s(bf_lo(uu[q].y) * bf_lo(m.y), bf_hi(uu[q].y) * bf_hi(m.y));
        o.z = cvtpk_s(bf_lo(uu[q].z) * bf_lo(m.z), bf_hi(uu[q].z) * bf_hi(m.z)); o.w = cvtpk_s(bf_lo(uu[q].w) * bf_lo(m.w), bf_hi(uu[q].w) * bf_hi(m.w));
        *(GAS v4u*)(AB + pg8::img_off(row0 + t, chunk * 8, 16)) = o; }
    int le_ = lane; asm volatile("" : "+v"(le_)); const int tide = wid * 64 + le_;
    SG_MERGE(0, tide)
    SG_MLOAD(1, tide)
    int lf_ = lane; asm volatile("" : "+v"(lf_)); const int tidf = wid * 64 + lf_;
    SG_MERGE(1, tidf)
#undef SG_MLOAD
#undef SG_MERGE
    __syncthreads();
}

typedef float f32x2 __attribute__((ext_vector_type(2)));
__device__ __forceinline__ f32x2 bf_pair(unsigned w) { return (f32x2){bf_lo(w), bf_hi(w)}; }
__device__ __forceinline__ void conv_pair(Frame& F, int pair) {
    LAS unsigned char* lds = F.lds; int lane = mk_lane_id(); asm volatile("" : "+v"(lane)); const int wid = F.wave, tid = wid * 64 + lane;
    const int b = pair >> 5, tA = (pair & 31) * 128;
    const bf16* P1 = (const bf16*)(F.ws + WS_P1); bf16* CD = (bf16*)(F.ws + WS_CD);
    {
        v4u v[12];
#pragma unroll
        for (int i = 0; i < 12; ++i) { const int idx = i * 512 + tid, r = idx >> 6, pc = idx & 63, t = tA - 30 + r; v[i] = (v4u){0u, 0u, 0u, 0u};
            if (idx < 94 * 64 && t >= 0) v[i] = *(const GAS v4u*)(P1 + pg8::kt_off(b * SEQ + t, pc * 8, 24)); }
        f32x4 wv[8];
#pragma unroll
        for (int i = 0; i < 8; ++i) { const int idx = i * 512 + tid; wv[i] = (f32x4){0.f, 0.f, 0.f, 0.f}; if (idx < 31 * 128) wv[i] = *(const GAS f32x4*)(F.in[12] + (size_t)idx * 4); }
#pragma unroll
        for (int i = 0; i < 12; ++i) { const int idx = i * 512 + tid, r = idx >> 6, pc = idx & 63; if (idx < 94 * 64) *(LAS v4u*)(lds + r * 1024 + pc * 16) = v[i]; }
#pragma unroll
        for (int i = 0; i < 8; ++i) { const int idx = i * 512 + tid; if (idx < 31 * 128) { u32x2 w; w.x = cvtpk_s(wv[i][0], wv[i][1]); w.y = cvtpk_s(wv[i][2], wv[i][3]); *(LAS u32x2*)(lds + 94 * 1024 + idx * 8) = w; } }
    }
    __syncthreads();
    const LAS unsigned char* wrow = lds + 94 * 1024 + lane * 16;
#pragma nounroll
    for (int half = 0; half < 2; ++half) {
        int ln = lane; asm volatile("" : "+v"(ln)); const int c0 = 8 * ln;
        const int t0 = tA + 64 * half, row0 = b * SEQ + t0, tw = t0 + 8 * wid;
        const int rwrap = half ? 30 - 8 * wid : 0;
        const LAS unsigned char* xlo = lds + (8 * wid + 64) * 1024 + ln * 16;
        const LAS unsigned char* xhi = lds + (8 * wid - (half ? 30 : 0)) * 1024 + ln * 16;
        v4u gx[10], gg[8];
#pragma unroll
        for (int i = 0; i < 10; ++i) { const int t = tw - 2 + i; gx[i] = (v4u){0u, 0u, 0u, 0u}; if (t >= 0) gx[i] = *(const GAS v4u*)(P1 + pg8::kt_off(b * SEQ + t, 1024 + c0, 24)); }
        f32x2 acc[8][4];
        { const f32x4 ba = *(const GAS f32x4*)(F.in[13] + c0), bb = *(const GAS f32x4*)(F.in[13] + c0 + 4);
#pragma unroll
          for (int o = 0; o < 8; ++o) { acc[o][0] = (f32x2){ba[0], ba[1]}; acc[o][1] = (f32x2){ba[2], ba[3]}; acc[o][2] = (f32x2){bb[0], bb[1]}; acc[o][3] = (f32x2){bb[2], bb[3]}; } }
        asm volatile("" ::: "memory");
        f32x2 wt[8][4];
#define XADDR(r) (((r) < rwrap ? xlo : xhi) + (r) * 1024)
        v4u xq = *(const LAS v4u*)XADDR(0), wq = *(const LAS v4u*)(wrow);
#define CONV_ROW(r) { \
        const v4u xr = xq, wp = wq; \
        if ((r) + 1 < 38) xq = *(const LAS v4u*)XADDR((r) + 1); \
        if ((r) + 1 <= 30) wq = *(const LAS v4u*)(wrow + ((r) + 1) * 1024); \
        if ((r) <= 30) { wt[(r) & 7][0] = bf_pair(wp.x); wt[(r) & 7][1] = bf_pair(wp.y); wt[(r) & 7][2] = bf_pair(wp.z); wt[(r) & 7][3] = bf_pair(wp.w); } \
        const f32x2 x0 = bf_pair(xr.x), x1 = bf_pair(xr.y), x2 = bf_pair(xr.z), x3 = bf_pair(xr.w); \
        _Pragma("unroll") for (int o = 0; o < 8; ++o) { const int j = (r) - o; if (j >= 0 && j <= 30) { \
            acc[o][0] = __builtin_elementwise_fma(wt[j & 7][0], x0, acc[o][0]); acc[o][1] = __builtin_elementwise_fma(wt[j & 7][1], x1, acc[o][1]); \
            acc[o][2] = __builtin_elementwise_fma(wt[j & 7][2], x2, acc[o][2]); acc[o][3] = __builtin_elementwise_fma(wt[j & 7][3], x3, acc[o][3]); \
            asm volatile("" : "+v"(acc[o][0]), "+v"(acc[o][1]), "+v"(acc[o][2]), "+v"(acc[o][3])); } } \
        asm volatile("" ::: "memory"); }
        CONV_ROW(0) CONV_ROW(1) CONV_ROW(2) CONV_ROW(3) CONV_ROW(4) CONV_ROW(5) CONV_ROW(6) CONV_ROW(7)
        CONV_ROW(8) CONV_ROW(9) CONV_ROW(10) CONV_ROW(11) CONV_ROW(12) CONV_ROW(13) CONV_ROW(14) CONV_ROW(15)
        CONV_ROW(16) CONV_ROW(17) CONV_ROW(18) CONV_ROW(19) CONV_ROW(20) CONV_ROW(21) CONV_ROW(22) CONV_ROW(23)
        CONV_ROW(24) CONV_ROW(25) CONV_ROW(26) CONV_ROW(27) CONV_ROW(28) CONV_ROW(29) CONV_ROW(30) CONV_ROW(31)
        CONV_ROW(32) CONV_ROW(33) CONV_ROW(34) CONV_ROW(35) CONV_ROW(36) CONV_ROW(37)
#undef CONV_ROW
#undef XADDR
        asm volatile("" ::: "memory");
        int l2 = ln; asm volatile("" : "+v"(l2)); const int c1 = 8 * l2, tid2 = wid * 64 + l2;
#pragma unroll
        for (int o = 0; o < 8; ++o) gg[o] = *(const GAS v4u*)(P1 + pg8::kt_off(b * SEQ + tw + o, 512 + c1, 24));
        v4u nb[8];
        if (half == 0) {
#pragma unroll
            for (int i = 0; i < 8; ++i) { const int idx = i * 512 + tid2, r = idx >> 6, pc = idx & 63; nb[i] = *(const GAS v4u*)(P1 + pg8::kt_off(b * SEQ + tA + 64 + r, pc * 8, 24)); }
        }
        float st[16];
#pragma unroll
        for (int o = 0; o < 8; ++o) { float s1 = 0.f, s2 = 0.f;
#pragma unroll
            for (int c = 0; c < 4; ++c) { s1 += acc[o][c][0] + acc[o][c][1]; s2 += acc[o][c][0] * acc[o][c][0] + acc[o][c][1] * acc[o][c][1]; }
            st[o] = s1; st[8 + o] = s2; }
        reduce16(st, l2);
        LAS float* sw = (LAS float*)(lds + AUX_OFF) + wid * 16;
        if ((l2 & 3) == 0) sw[red16_idx(l2)] = st[0];
        asm volatile("" ::: "memory");
        const f32x4 ga = *(const GAS f32x4*)(F.in[14] + c1), gb = *(const GAS f32x4*)(F.in[14] + c1 + 4), la = *(const GAS f32x4*)(F.in[15] + c1), lb = *(const GAS f32x4*)(F.in[15] + c1 + 4);
        const float lg[8] = {ga[0], ga[1], ga[2], ga[3], gb[0], gb[1], gb[2], gb[3]}, lbv[8] = {la[0], la[1], la[2], la[3], lb[0], lb[1], lb[2], lb[3]};
#pragma unroll
        for (int o = 0; o < 8; ++o) { const float mean = sw[o] * (1.0f / 512.0f), var = fmaxf(sw[8 + o] * (1.0f / 512.0f) - mean * mean, 0.f), rstd = __builtin_amdgcn_rsqf(var + 1e-6f);
            float y[8];
#pragma unroll
            for (int c = 0; c < 8; ++c) { const float z = (acc[o][c >> 1][c & 1] - mean) * rstd * lg[c] + lbv[c]; y[c] = z * pg8::sigmoid_f(z); }
            v4u ov; ov.x = cvtpk_s(y[0], y[1]); ov.y = cvtpk_s(y[2], y[3]); ov.z = cvtpk_s(y[4], y[5]); ov.w = cvtpk_s(y[6], y[7]);
            *(GAS v4u*)(CD + pg8::img_off(row0 + 8 * wid + o, c1, 16)) = ov; }
        asm volatile("" ::: "memory");
        { const GAS float* dw = (const GAS float*)F.in[16] + c1;
          const f32x4 d0a = *(const GAS f32x4*)(dw), d0b = *(const GAS f32x4*)(dw + 4), d1a = *(const GAS f32x4*)(dw + 512), d1b = *(const GAS f32x4*)(dw + 516), d2a = *(const GAS f32x4*)(dw + 1024), d2b = *(const GAS f32x4*)(dw + 1028);
          const float w0[8] = {d0a[0], d0a[1], d0a[2], d0a[3], d0b[0], d0b[1], d0b[2], d0b[3]}, w1[8] = {d1a[0], d1a[1], d1a[2], d1a[3], d1b[0], d1b[1], d1b[2], d1b[3]}, w2[8] = {d2a[0], d2a[1], d2a[2], d2a[3], d2b[0], d2b[1], d2b[2], d2b[3]};
#pragma unroll
          for (int o = 0; o < 8; ++o) { const v4u xa = gx[o], xb = gx[o + 1], xc = gx[o + 2], gv = gg[o];
              const float A[8] = {bf_lo(xa.x), bf_hi(xa.x), bf_lo(xa.y), bf_hi(xa.y), bf_lo(xa.z), bf_hi(xa.z), bf_lo(xa.w), bf_hi(xa.w)}, B[8] = {bf_lo(xb.x), bf_hi(xb.x), bf_lo(xb.y), bf_hi(xb.y), bf_lo(xb.z), bf_hi(xb.z), bf_lo(xb.w), bf_hi(xb.w)};
              const float C[8] = {bf_lo(xc.x), bf_hi(xc.x), bf_lo(xc.y), bf_hi(xc.y), bf_lo(xc.z), bf_hi(xc.z), bf_lo(xc.w), bf_hi(xc.w)}, Gv[8] = {bf_lo(gv.x), bf_hi(gv.x), bf_lo(gv.y), bf_hi(gv.y), bf_lo(gv.z), bf_hi(gv.z), bf_lo(gv.w), bf_hi(gv.w)};
              float d[8];
#pragma unroll
              for (int c = 0; c < 8; ++c) d[c] = Gv[c] * (w0[c] * A[c] + w1[c] * B[c] + w2[c] * C[c]);
              v4u ov; ov.x = cvtpk_s(d[0], d[1]); ov.y = cvtpk_s(d[2], d[3]); ov.z = cvtpk_s(d[4], d[5]); ov.w = cvtpk_s(d[6], d[7]);
              *(GAS v4u*)(CD + pg8::img_off(row0 + 8 * wid + o, 512 + c1, 16)) = ov; } }
        __syncthreads();
        if (half == 0) {
#pragma unroll
            for (int i = 0; i < 8; ++i) { const int idx = i * 512 + tid2, r = idx >> 6, pc = idx & 63; *(LAS v4u*)(lds + r * 1024 + pc * 16) = nb[i]; }
            __syncthreads();
        }
    }
}

#ifndef MK_REP_SG
#define MK_REP_SG 1
#endif
#ifndef MK_REP_CONV
#define MK_REP_CONV 1
#endif
constexpr int NPHASES = 12;
struct Args { const float* in[22]; float* out; unsigned char* ws; int ph_lo, ph_hi; };
__global__ void __launch_bounds__(NWAVES * 64, 2) mk_fwd(Args args) {
    extern __shared__ __attribute__((aligned(16))) unsigned char lds_raw[];
    Frame F;
    F.lds = (LAS unsigned char*)lds_raw;
    F.MISC = (volatile LAS unsigned*)(F.lds + MISC_OFF);
    F.wave = __builtin_amdgcn_readfirstlane((int)threadIdx.x >> 6);
    F.G = gridDim.x; { const int bx = blockIdx.x; F.vcu = (F.G % 8 == 0) ? (bx % 8) * (F.G / 8) + bx / 8 : bx; }
    unsigned char* ws = args.ws; F.ws = ws; F.out = args.out;
#pragma unroll
    for (int i = 0; i < 22; ++i) F.in[i] = args.in[i];
    F.ctl = (gu32*)(ws + WS_CTL);
    for (int u = threadIdx.x; u < 1024 / 4; u += NWAVES * 64) ((LAS unsigned*)(F.lds + LDSCTL_OFF))[u] = 0u;
    __syncthreads();
    const int lo = args.ph_lo, hi = args.ph_hi;
    XcdBarrier bar; bar.bar = (unsigned*)(F.ctl + CW_BAR); bar.x = 0; bar.st = nullptr;
    if (hi - lo > 1) bar = xcd_barrier_post((unsigned*)(F.ctl + CW_BAR), F.MISC + 8);
#define IN(k) (lo <= (k) && (k) < hi)
#define SEAM(k) do { if (IN(k) && IN((k) + 1)) xcd_barrier(bar); } while (0)
    float* rss = (float*)(ws + WS_RSS);
    bf16* XB = (bf16*)(ws + WS_XB);
    LAS unsigned char* xs = F.lds + XP_OFF + F.wave * 2304;

    if (IN(0)) { p0_prologue(F); SEAM(0); }
    if (IN(1)) {
        pg8::Gemm g{XB, (const bf16*)(ws + WS_W0IN), T, AB_IN, DM}; pg8::StaticOrder S; S.init(T, AB_IN, F.G, (int)blockIdx.x);
        pg8::EpiIn0 E{rss, (bf16*)(ws + WS_UV), (bf16*)(ws + WS_Q), (bf16*)(ws + WS_K), (bf16*)(ws + WS_V), F.in[7], F.in[8], (const float*)(ws + WS_ROPE), xs};
        pg8::gemm_phase<pg8::EpiIn0, pg8::StaticOrder, true, true>(F.lds + RING_OFF, g, S, E, F.wave);
        SEAM(1);
    }
    if (IN(2)) {
        att::attn_phase(F.lds, F.vcu, F.G, (const bf16*)(ws + WS_Q), (const bf16*)(ws + WS_K), (const bf16*)(ws + WS_V), (bf16*)(ws + WS_Q), (float*)(ws + WS_LSE), F.wave);
        SEAM(2);
    }
    if (IN(3)) {
        for (int rep = 0; rep < MK_REP_SG; ++rep) for (int u = F.vcu; u < T / 128; u += F.G) sg_unit(F, u);
        SEAM(3);
    }
    if (IN(4)) {
        pg8::Gemm g{(const bf16*)(ws + WS_AB), (const bf16*)(ws + WS_W0OUT), T, DM, DM}; pg8::StaticOrder S; S.init(T, DM, F.G, (int)blockIdx.x);
        pg8::EpiRes E{XB, nullptr, rss + T, xs};
        pg8::gemm_phase<pg8::EpiRes, pg8::StaticOrder, true, true>(F.lds + RING_OFF, g, S, E, F.wave);
        SEAM(4);
    }
    if (IN(5)) {
        pg8::Gemm g{XB, (const bf16*)(ws + WS_W0GU), T, GU_N, DM}; pg8::StaticOrder S; S.init(T, GU_N, F.G, (int)blockIdx.x);
        pg8::EpiGUT<true> E{rss + T, (bf16*)(ws + WS_ACT), DFF, xs, (const pg8::DwTab*)(ws + WS_DWTAB)};
        pg8::gemm_phase<pg8::EpiGUT<true>, pg8::StaticOrder, true, true>(F.lds + RING_OFF, g, S, E, F.wave);
        SEAM(5);
    }
    if (IN(6)) {
        pg8::Gemm g{(const bf16*)(ws + WS_ACT), (const bf16*)(ws + WS_W0D), T, DM, DFF}; pg8::StaticOrder S; S.init(T, DM, F.G, (int)blockIdx.x);
        pg8::EpiRes E{XB, nullptr, rss + 2 * T, xs};
        pg8::gemm_phase<pg8::EpiRes, pg8::StaticOrder, true, true>(F.lds + RING_OFF, g, S, E, F.wave);
        SEAM(6);
    }
    if (IN(7)) {
        pg8::Gemm g{XB, (const bf16*)(ws + WS_W1IN), T, CD_IN, DM}; pg8::StaticOrder S; S.init(T, CD_IN, F.G, (int)blockIdx.x);
        pg8::EpiIn1 E{rss + 2 * T, (bf16*)(ws + WS_P1), xs};
        pg8::gemm_phase<pg8::EpiIn1, pg8::StaticOrder, true, true>(F.lds + RING_OFF, g, S, E, F.wave);
        SEAM(7);
    }
    if (IN(8)) {
        for (int rep = 0; rep < MK_REP_CONV; ++rep) for (int u = F.vcu; u < T / 128; u += F.G) conv_pair(F, u);
        SEAM(8);
    }
    if (IN(9)) {
        pg8::Gemm g{(const bf16*)(ws + WS_CD), (const bf16*)(ws + WS_W1OUT), T, DM, DM}; pg8::StaticOrder S; S.init(T, DM, F.G, (int)blockIdx.x);
        pg8::EpiRes E{XB, nullptr, rss + 3 * T, xs};
        pg8::gemm_phase<pg8::EpiRes, pg8::StaticOrder, true, true>(F.lds + RING_OFF, g, S, E, F.wave);
        SEAM(9);
    }
    if (IN(10)) {
        pg8::Gemm g{XB, (const bf16*)(ws + WS_W1GU), T, GU_N, DM}; pg8::StaticOrder S; S.init(T, GU_N, F.G, (int)blockIdx.x);
        pg8::EpiGUT<false> E{rss + 3 * T, (bf16*)(ws + WS_ACT), DFF, xs, nullptr};
        pg8::gemm_phase<pg8::EpiGUT<false>, pg8::StaticOrder, true, true>(F.lds + RING_OFF, g, S, E, F.wave);
        SEAM(10);
    }
    if (IN(11)) {
        pg8::Gemm g{(const bf16*)(ws + WS_ACT), (const bf16*)(ws + WS_W1D), T, DM, DFF}; pg8::StaticOrder S; S.init(T, DM, F.G, (int)blockIdx.x);
        pg8::EpiRes E{XB, F.out, nullptr, xs};
        pg8::gemm_phase<pg8::EpiRes, pg8::StaticOrder, true, true>(F.lds + RING_OFF, g, S, E, F.wave);
    }
#undef IN
#undef SEAM
}

#ifndef MK_PER_PHASE
#define MK_PER_PHASE 0
#endif
extern "C" void kernel_launch(void* const* d_in, const int* in_sizes, int n_in, void* d_out, int out_size, void* d_ws, size_t ws_size, hipStream_t stream) {
    static int grid = 0;
    if (grid == 0) {
        if (n_in != 22 || in_sizes[0] != T * DM || out_size != T * DM || ws_size < WS_END) { fprintf(stderr, "kernel_launch: unexpected shapes: n_in %d in0 %d out %d ws %zu (need %zu); nothing launched\n", n_in, n_in > 0 ? in_sizes[0] : -1, out_size, ws_size, (size_t)WS_END); grid = -1; return; }
        int dev = 0, cus = 0, per_cu = 0;
        if (hipGetDevice(&dev) != hipSuccess || hipDeviceGetAttribute(&cus, hipDeviceAttributeMultiprocessorCount, dev) != hipSuccess) { fprintf(stderr, "kernel_launch: device query failed\n"); grid = -1; return; }
        if (hipFuncSetAttribute((const void*)mk_fwd, hipFuncAttributeMaxDynamicSharedMemorySize, LDS_BYTES) != hipSuccess) { fprintf(stderr, "kernel_launch: hipFuncSetAttribute failed\n"); grid = -1; return; }
        if (hipOccupancyMaxActiveBlocksPerMultiprocessor(&per_cu, (const void*)mk_fwd, NWAVES * 64, LDS_BYTES) != hipSuccess || per_cu < 1) { fprintf(stderr, "kernel_launch: occupancy query says %d blocks per CU\n", per_cu); per_cu = 1; }
        (void)hipGetLastError();
        grid = cus;
        if (grid % 8 != 0 || grid > 256) grid = (grid / 8) * 8 > 256 ? 256 : (grid / 8) * 8;
    }
    if (grid <= 0) return;
    (void)hipMemsetAsync((char*)d_ws + WS_CTL, 0, CTL_ZERO_BYTES, stream);
    Args a{};
    for (int i = 0; i < 22; ++i) a.in[i] = (const float*)d_in[i];
    a.out = (float*)d_out; a.ws = (unsigned char*)d_ws;
#if MK_PER_PHASE
    for (int p = 0; p < NPHASES; ++p) { a.ph_lo = p; a.ph_hi = p + 1; hipLaunchKernelGGL(mk_fwd, dim3(grid), dim3(NWAVES * 64), LDS_BYTES, stream, a); }
#else
    a.ph_lo = 0; a.ph_hi = NPHASES;
    hipLaunchKernelGGL(mk_fwd, dim3(grid), dim3(NWAVES * 64), LDS_BYTES, stream, a);
#endif
    const hipError_t le = hipPeekAtLastError();
    if (le != hipSuccess) fprintf(stderr, "kernel_launch: launch failed: %s\n", hipGetErrorName(le));
}
```

```cpp
#include <hip/hip_runtime.h>
#include <cstdio>
#include <cstdint>
__device__ __forceinline__ int mk_lane_id() { return (int)__builtin_amdgcn_mbcnt_hi(~0u, __builtin_amdgcn_mbcnt_lo(~0u, 0u)); }
namespace pg8 {
#define PG8_LAS __attribute__((address_space(3)))
typedef unsigned short bf16_t;
typedef short bf16x8 __attribute__((ext_vector_type(8)));
typedef float f32x4 __attribute__((ext_vector_type(4)));
typedef unsigned u32x4 __attribute__((ext_vector_type(4)));
constexpr int BM = 256, BK = 64, HALF = 128, HTB = HALF * BK * 2  , STAGE_BYTES = 8 * HTB, NXCD = 8, WGM = 8;

__host__ __device__ __forceinline__ int lds_byte(int r, int c) { const int st = (r >> 4) * 2 + (c >> 5), rr = r & 15, cc = c & 31, ob = rr * 64 + cc * 2; return st * 1024 + (ob ^ (((ob >> 9) & 1) << 5)); }
__host__ __device__ __forceinline__ void stage_rc(int b, int& R, int& C) { const int st = b / 1024, sb = b % 1024, swz = sb ^ (((sb >> 9) & 1) << 5); R = (st >> 1) * 16 + swz / 64; C = (st & 1) * 32 + (swz % 64) / 2; }
__host__ __device__ __forceinline__ int perm32(int rho) { const int n = rho >> 4, i = rho & 15; return 8 * (i >> 2) + 4 * n + (i & 3); }

struct Unit { int pm, pn; };
struct Gemm { const bf16_t* A; const bf16_t* Bt; int M, N, K; };

struct StaticOrder {
    int nM, nN, nwg, G, c;
    __host__ __device__ void init(int M, int N, int G_, int c_) { nM = M / BM; nN = N / BM; nwg = nM * nN; G = G_; c = c_; }
    __host__ __device__ bool next(int i, Unit& u) const {
        const long L = (long)i * G + c; if (L >= nwg) return false;
        int wgid = (int)L; { const int q = nwg / NXCD, r = nwg % NXCD, xcd = wgid % NXCD, off = wgid / NXCD; wgid = (xcd < r ? xcd * (q + 1) : r * (q + 1) + (xcd - r) * q) + off; }
        const int nig = WGM * nN, gid = wgid / nig, fm = gid * WGM, gsz = (nM - fm) < WGM ? (nM - fm) : WGM;
        u.pm = fm + ((wgid % nig) % gsz); u.pn = (wgid % nig) / gsz; return true;
    }
    __device__ __forceinline__ void a_ready(const Unit&) const {}
    __device__ __forceinline__ void done(const Unit&) const {}
};

__device__ __forceinline__ unsigned cvt_pk_bf16(float lo, float hi) { unsigned r; asm volatile("v_cvt_pk_bf16_f32 %0, %1, %2" : "=v"(r) : "v"(lo), "v"(hi)); return r; }
typedef float f32x2 __attribute__((ext_vector_type(2)));
__device__ __forceinline__ f32x2 gelu_pk(f32x2 v) {
    const f32x2 av = __builtin_elementwise_abs(v), d = av * 0.2316418882f + 1.0f;
    f32x2 t; t.x = __builtin_amdgcn_rcpf(d.x); t.y = __builtin_amdgcn_rcpf(d.y);
    f32x2 q = t * 0.5307027145f + (-0.7265760135f); q = q * t + 0.7107068705f; q = q * t + (-0.142248368f); q = q * t + 0.127414796f; q = q * t;
    const f32x2 s = (v * v) * (-0.72134752044f);
    f32x2 e; e.x = __builtin_amdgcn_exp2f(s.x); e.y = __builtin_amdgcn_exp2f(s.y);
    const f32x2 m = v * (q * e), r = v - m;
    f32x2 o; o.x = v.x < 0.f ? m.x : r.x; o.y = v.y < 0.f ? m.y : r.y; return o;
}
template <class Epi, class Sched, bool ALIGN_EPI = false, bool SP2 = false>
__device__ __forceinline__ void gemm_phase(PG8_LAS unsigned char* lds, const Gemm g, const Sched& S, const Epi& E, const int wave_in) {
    int lane_ = mk_lane_id(); asm volatile("" : "+v"(lane_));
    const int lane = lane_, wid = wave_in, tid = wid * 64 + lane, wr = wid >> 2, wc = wid & 3, fr = lane & 15, fq = lane >> 4;
    const int K = g.K, nt = K / BK;
    unsigned voffA[2], voffB[2];
#pragma unroll
    for (int i = 0; i < 2; ++i) voffA[i] = voffB[i] = (unsigned)(tid * 16 + i * 8192);
    const size_t kstep = (size_t)(BM * BK * 2);
    const size_t hstep = (size_t)HALF * BK * 2;
    const size_t tstep = (size_t)(K / BK) * kstep;
    const unsigned ldsw = (unsigned)wid * 1024u;
    const int aoff = lds_byte(wr * 64 + fr, fq * 8), boff = lds_byte(wc * 32 + fr, fq * 8);
#define PG8_SA(b, h) (((b) * 2 + (h)) * HTB)
#define PG8_SB(b, h) ((4 + (b) * 2 + (h)) * HTB)
#define PG8_STAGE(bufoff, gbase, voff) do { _Pragma("unroll") for (int _i = 0; _i < 2; ++_i) \
        __builtin_amdgcn_global_load_lds((const unsigned*)((const char*)(gbase) + (voff)[_i]), (PG8_LAS unsigned*)(lds + (bufoff) + ldsw + _i * 8192), 16, 0, 0); } while (0)
#define PG8_LDA(dst, b, h) do { _Pragma("unroll") for (int m = 0; m < 4; ++m) _Pragma("unroll") for (int k = 0; k < 2; ++k) dst[m][k] = *(const PG8_LAS bf16x8*)(lds + PG8_SA(b, h) + aoff + m * 2048 + k * 1024); } while (0)
#define PG8_LDB(dst, b, h) do { _Pragma("unroll") for (int n = 0; n < 2; ++n) _Pragma("unroll") for (int k = 0; k < 2; ++k) dst[n][k] = *(const PG8_LAS bf16x8*)(lds + PG8_SB(b, h) + boff + n * 2048 + k * 1024); } while (0)
#define PG8_MMA(ai, bj, At, Bt) do { __builtin_amdgcn_s_setprio(1); _Pragma("unroll") for (int m = 0; m < 4; ++m) _Pragma("unroll") for (int n = 0; n < 2; ++n) _Pragma("unroll") for (int k = 0; k < 2; ++k) \
        acc[ai][bj][m][n] = __builtin_amdgcn_mfma_f32_16x16x32_bf16(Bt[n][k], At[m][k], acc[ai][bj][m][n], 0, 0, 0); __builtin_amdgcn_s_setprio(0); } while (0)
#define PG8_WAIT_V(n) asm volatile("s_waitcnt vmcnt(" #n ")" ::: "memory")
#define PG8_WAIT_L(n) asm volatile("s_waitcnt lgkmcnt(" #n ")" ::: "memory")
#define PG8_BAR __builtin_amdgcn_s_barrier()
#define PG8_SCHED __builtin_amdgcn_sched_barrier(0)
    Unit cur, nxt; int ui = 0;
    if (!S.next(0, cur)) return;
    f32x4 acc[2][2][4][2];
#pragma unroll
    for (int a = 0; a < 2; ++a)
#pragma unroll
        for (int b = 0; b < 2; ++b)
#pragma unroll
            for (int m = 0; m < 4; ++m)
#pragma unroll
                for (int n = 0; n < 2; ++n) acc[a][b][m][n] = (f32x4){0.f, 0.f, 0.f, 0.f};
    bf16x8 At[4][2], B0[2][2], B1[2][2];
    const char* cA = (const char*)g.A + (size_t)cur.pm * tstep; const char* cB = (const char*)g.Bt + (size_t)cur.pn * tstep;
    S.a_ready(cur);
    if constexpr (SP2) {
        PG8_STAGE(PG8_SB(0, 0), cB, voffB); PG8_STAGE(PG8_SB(0, 1), cB + hstep, voffB); PG8_STAGE(PG8_SA(0, 0), cA, voffA); PG8_STAGE(PG8_SA(0, 1), cA + hstep, voffA);
        if (wr == 1) PG8_BAR;
        PG8_WAIT_V(2); PG8_BAR;
        PG8_STAGE(PG8_SB(1, 0), cB + kstep, voffB); PG8_STAGE(PG8_SA(1, 0), cA + kstep, voffA); PG8_STAGE(PG8_SB(1, 1), cB + hstep + kstep, voffB);
        PG8_WAIT_V(6); PG8_BAR;
    } else {
        PG8_STAGE(PG8_SB(0, 0), cB, voffB); PG8_STAGE(PG8_SA(0, 0), cA, voffA); PG8_STAGE(PG8_SB(0, 1), cB + hstep, voffB); PG8_STAGE(PG8_SA(0, 1), cA + hstep, voffA);
        if (wr == 1) PG8_BAR;
        PG8_WAIT_V(4); PG8_BAR;
        PG8_STAGE(PG8_SB(1, 0), cB + kstep, voffB); PG8_STAGE(PG8_SA(1, 0), cA + kstep, voffA); PG8_STAGE(PG8_SB(1, 1), cB + hstep + kstep, voffB);
        PG8_WAIT_V(6); PG8_BAR;
    }
    for (;;) {
        const bool has_next = S.next(ui + 1, nxt);
        const char* nA = has_next ? (const char*)g.A + (size_t)nxt.pm * tstep : cA; const char* nB = has_next ? (const char*)g.Bt + (size_t)nxt.pn * tstep : cB;
        for (int t = 0; t < nt; t += 2) {
            const bool last = (t == nt - 2);
            const char* a1 = cA + (size_t)(t + 1) * kstep;
            const char* a2 = last ? nA : cA + (size_t)(t + 2) * kstep; const char* b2 = last ? nB : cB + (size_t)(t + 2) * kstep;
            const char* a3 = a2 + kstep; const char* b3 = b2 + kstep;
            if (last) E.prefetch(cur, wr, fq * 16 + fr);
            if (last && has_next) S.a_ready(nxt);
            if constexpr (SP2) {
            PG8_LDB(B0, 0, 0); PG8_LDB(B1, 0, 1); PG8_SCHED; PG8_LDA(At, 0, 0); PG8_STAGE(PG8_SA(1, 1), a1 + hstep, voffA);
            PG8_WAIT_V(8); PG8_WAIT_L(0); PG8_BAR; PG8_MMA(0, 0, At, B0); PG8_MMA(0, 1, At, B1); PG8_BAR; PG8_SCHED;
            PG8_LDA(At, 0, 1); PG8_STAGE(PG8_SB(0, 0), b2, voffB); PG8_STAGE(PG8_SB(0, 1), b2 + hstep, voffB); PG8_STAGE(PG8_SA(0, 0), a2, voffA);
            PG8_WAIT_V(8); PG8_WAIT_L(0); PG8_BAR; PG8_MMA(1, 0, At, B0); PG8_MMA(1, 1, At, B1); PG8_BAR; PG8_SCHED;
            PG8_LDB(B0, 1, 0); PG8_LDB(B1, 1, 1); PG8_SCHED; PG8_LDA(At, 1, 0); PG8_STAGE(PG8_SA(0, 1), a2 + hstep, voffA);
            PG8_WAIT_V(8); PG8_WAIT_L(0); PG8_BAR; PG8_MMA(0, 0, At, B0); PG8_MMA(0, 1, At, B1); PG8_BAR; PG8_SCHED;
            PG8_LDA(At, 1, 1); PG8_STAGE(PG8_SB(1, 0), b3, voffB); PG8_STAGE(PG8_SB(1, 1), b3 + hstep, voffB); PG8_STAGE(PG8_SA(1, 0), a3, voffA);
            PG8_WAIT_V(8); PG8_WAIT_L(0); PG8_BAR; PG8_MMA(1, 0, At, B0); PG8_MMA(1, 1, At, B1); PG8_BAR; PG8_SCHED;
            } else {
            PG8_LDB(B0, 0, 0); PG8_SCHED; PG8_LDA(At, 0, 0); PG8_STAGE(PG8_SA(1, 1), a1 + hstep, voffA);
            PG8_WAIT_L(8); PG8_BAR; PG8_WAIT_L(0); PG8_MMA(0, 0, At, B0); PG8_BAR; PG8_SCHED;
            PG8_LDB(B1, 0, 1); PG8_STAGE(PG8_SB(0, 0), b2, voffB);
            PG8_BAR; PG8_WAIT_L(0); PG8_MMA(0, 1, At, B1); PG8_BAR;
            PG8_LDA(At, 0, 1); PG8_STAGE(PG8_SA(0, 0), a2, voffA);
            PG8_BAR; PG8_WAIT_L(0); PG8_MMA(1, 0, At, B0); PG8_BAR; PG8_SCHED;
            PG8_STAGE(PG8_SB(0, 1), b2 + hstep, voffB);
            PG8_WAIT_V(6); PG8_BAR; PG8_MMA(1, 1, At, B1); PG8_BAR;
            PG8_LDB(B0, 1, 0); PG8_SCHED; PG8_LDA(At, 1, 0); PG8_STAGE(PG8_SA(0, 1), a2 + hstep, voffA);
            PG8_WAIT_L(8); PG8_BAR; PG8_WAIT_L(0); PG8_MMA(0, 0, At, B0); PG8_BAR; PG8_SCHED;
            PG8_LDB(B1, 1, 1); PG8_STAGE(PG8_SB(1, 0), b3, voffB);
            PG8_BAR; PG8_WAIT_L(0); PG8_MMA(0, 1, At, B1); PG8_BAR;
            PG8_LDA(At, 1, 1); PG8_STAGE(PG8_SA(1, 0), a3, voffA);
            PG8_BAR; PG8_WAIT_L(0); PG8_MMA(1, 0, At, B0); PG8_BAR; PG8_SCHED;
            PG8_STAGE(PG8_SB(1, 1), b3 + hstep, voffB);
            PG8_WAIT_V(6); PG8_BAR; PG8_MMA(1, 1, At, B1); PG8_BAR;
            }
        }
        if constexpr (ALIGN_EPI) { if (wr == 0) PG8_BAR; }
        if constexpr (!Epi::AFTER_DRAIN) { E(acc, cur, wr, wc, fr, fq); S.done(cur); }
        if (!has_next) break;
#pragma unroll
        for (int a = 0; a < 2; ++a)
#pragma unroll
            for (int b = 0; b < 2; ++b)
#pragma unroll
                for (int m = 0; m < 4; ++m)
#pragma unroll
                    for (int n = 0; n < 2; ++n) acc[a][b][m][n] = (f32x4){0.f, 0.f, 0.f, 0.f};
        cur = nxt; cA = nA; cB = nB; ++ui;
        if constexpr (ALIGN_EPI) { if (wr == 1) PG8_BAR; }
    }
    PG8_WAIT_V(0);
    if constexpr (!ALIGN_EPI) { if (wr == 0) PG8_BAR; }
    PG8_BAR;
    if constexpr (Epi::AFTER_DRAIN) { E.fused(acc, cur, wr, wc, fr, fq, lds, wid, lane); S.done(cur); }
#undef PG8_SA
#undef PG8_SB
#undef PG8_STAGE
#undef PG8_LDA
#undef PG8_LDB
#undef PG8_MMA
#undef PG8_WAIT_V
#undef PG8_WAIT_L
#undef PG8_BAR
#undef PG8_SCHED
}
}
namespace pg8 {
constexpr float NORM_EPS = 1e-6f;
typedef unsigned u32x2 __attribute__((ext_vector_type(2)));
__device__ __forceinline__ float sigmoid_f(float x) { return __builtin_amdgcn_rcpf(1.0f + __builtin_amdgcn_exp2f(-1.4426950408889634f * x)); }
__device__ __forceinline__ unsigned cvt2(float lo, float hi) { typedef float f2_t __attribute__((ext_vector_type(2))); typedef __bf16 b2_t __attribute__((ext_vector_type(2))); f2_t v = {lo, hi}; b2_t b = __builtin_convertvector(v, b2_t); return __builtin_bit_cast(unsigned, b); }
__device__ __forceinline__ u32x4 pack8(const f32x4 a, const f32x4 b) { u32x4 w; w.x = cvt2(a[0], a[1]); w.y = cvt2(a[2], a[3]); w.z = cvt2(b[0], b[1]); w.w = cvt2(b[2], b[3]); return w; }
__device__ __forceinline__ float dot4(const f32x4 a) { return (a[0] * a[0] + a[1] * a[1]) + (a[2] * a[2] + a[3] * a[3]); }

constexpr int XP_PITCH2 = 144, XP_PITCH1 = 80, XP_WAVE = 16 * XP_PITCH2;
__host__ __device__ __forceinline__ size_t kt_off(int row, int col, int ktiles) { return ((size_t)((row >> 8) * ktiles + (col >> 6)) * 256 + (row & 255)) * 64 + (col & 63); }
__host__ __device__ __forceinline__ size_t img_off(int row, int col, int ktiles) { return (((size_t)((row >> 8) * ktiles + (col >> 6)) * 2 + ((row >> 7) & 1)) * 16384 + lds_byte(row & 127, col & 63)) >> 1; }
__host__ __device__ __forceinline__ int invperm32(int j) { return 16 * ((j >> 2) & 1) + 4 * (j >> 3) + (j & 3); }
__host__ __device__ __forceinline__ size_t hm_off(int g, int b, int h, int t) { const int sh = 2 * g; return ((size_t)((((g * 8 + b) * 8 + h) << 12) + ((t & ((1 << sh) - 1)) << (12 - sh)) + (t >> sh))) * 64; }
__device__ __forceinline__ void xp_store2(PG8_LAS unsigned char* xs, int fr, int fq, const u32x4 w0, const u32x4 w1, bf16_t* base, int ld) {
    const int lane = fq * 16 + fr;
    *(PG8_LAS u32x4*)(xs + fr * XP_PITCH2 + fq * 16) = w0; *(PG8_LAS u32x4*)(xs + fr * XP_PITCH2 + 64 + fq * 16) = w1;
    const u32x4 a = *(const PG8_LAS u32x4*)(xs + (lane >> 3) * XP_PITCH2 + (lane & 7) * 16), b = *(const PG8_LAS u32x4*)(xs + ((lane >> 3) + 8) * XP_PITCH2 + (lane & 7) * 16);
    __builtin_nontemporal_store(a, (u32x4*)(base + (size_t)(lane >> 3) * ld + (lane & 7) * 8)); __builtin_nontemporal_store(b, (u32x4*)(base + (size_t)((lane >> 3) + 8) * ld + (lane & 7) * 8));
}
__device__ __forceinline__ void xp_put2(PG8_LAS unsigned char* xs, int fr, int fq, const u32x4 w0, const u32x4 w1, u32x4& a, u32x4& b) {
    const int lane = fq * 16 + fr;
    *(PG8_LAS u32x4*)(xs + fr * XP_PITCH2 + fq * 16) = w0; *(PG8_LAS u32x4*)(xs + fr * XP_PITCH2 + 64 + fq * 16) = w1;
    a = *(const PG8_LAS u32x4*)(xs + (lane >> 3) * XP_PITCH2 + (lane & 7) * 16); b = *(const PG8_LAS u32x4*)(xs + ((lane >> 3) + 8) * XP_PITCH2 + (lane & 7) * 16);
}
__device__ __forceinline__ void xp_put1(PG8_LAS unsigned char* xs, int fr, int fq, const u32x4 w0, u32x4& a) {
    const int lane = fq * 16 + fr;
    *(PG8_LAS u32x4*)(xs + fr * XP_PITCH1 + fq * 16) = w0;
    a = *(const PG8_LAS u32x4*)(xs + (lane >> 2) * XP_PITCH1 + (lane & 3) * 16);
}
__device__ __forceinline__ void nt16(const u32x4 v, bf16_t* p) { __builtin_nontemporal_store(v, (u32x4*)p); }
__device__ __forceinline__ f32x4 bf4_lo(unsigned a, unsigned b) { return (f32x4){__builtin_bit_cast(float, a << 16), __builtin_bit_cast(float, a & 0xffff0000u), __builtin_bit_cast(float, b << 16), __builtin_bit_cast(float, b & 0xffff0000u)}; }
struct EpiRes {
    static constexpr bool PERM = true, AFTER_DRAIN = false;
    __device__ __forceinline__ void prefetch(const Unit&, int, int) const {}
    bf16_t* xb; float* outf; float* rowss; PG8_LAS unsigned char* xs;
    __device__ __forceinline__ void operator()(const f32x4 (&acc)[2][2][4][2], const Unit& u, int wr, int wc, int fr, int fq) const {
        const int lane = fq * 16 + fr, rowg = u.pm * BM + wr * 64, colw = u.pn * BM + wc * 64;
        const int ob = fr * 64 + fq * 16, sw = ob ^ (((ob >> 9) & 1) << 5);
        bf16_t* const xw = xb + img_off(rowg, colw, 16) + (sw >> 1);
        u32x4 ga[8], gb[8];
#pragma unroll
        for (int i = 0; i < 8; ++i) { const bf16_t* g0 = xw + (i >> 2) * 8192 + (i & 3) * 1024; ga[i] = *(const u32x4*)g0; gb[i] = *(const u32x4*)(g0 + 512); }
#pragma unroll
        for (int ai = 0; ai < 2; ++ai)
#pragma unroll
            for (int m = 0; m < 4; ++m) {
                const int i = ai * 4 + m, row = rowg + ai * HALF + m * 16; const u32x4 r0 = ga[i], r1 = gb[i];
                const f32x4 v00 = acc[ai][0][m][0] + bf4_lo(r0.x, r0.y), v01 = acc[ai][0][m][1] + bf4_lo(r0.z, r0.w), v10 = acc[ai][1][m][0] + bf4_lo(r1.x, r1.y), v11 = acc[ai][1][m][1] + bf4_lo(r1.z, r1.w);
                if (outf) { float* o = outf + (size_t)row * 1024 + colw;
#pragma unroll
                    for (int bj = 0; bj < 2; ++bj) { const f32x4 x0 = bj ? v10 : v00, x1 = bj ? v11 : v01;
                        *(PG8_LAS f32x4*)(xs + fr * XP_PITCH2 + fq * 32) = x0; *(PG8_LAS f32x4*)(xs + fr * XP_PITCH2 + fq * 32 + 16) = x1;
                        const f32x4 a = *(const PG8_LAS f32x4*)(xs + (lane >> 3) * XP_PITCH2 + (lane & 7) * 16), b = *(const PG8_LAS f32x4*)(xs + ((lane >> 3) + 8) * XP_PITCH2 + (lane & 7) * 16);
                        __builtin_nontemporal_store(a, (f32x4*)(o + (size_t)(lane >> 3) * 1024 + bj * 32 + (lane & 7) * 4)); __builtin_nontemporal_store(b, (f32x4*)(o + (size_t)((lane >> 3) + 8) * 1024 + bj * 32 + (lane & 7) * 4)); } }
                else { bf16_t* g0 = xw + ai * 8192 + m * 1024; nt16(pack8(v00, v01), g0); nt16(pack8(v10, v11), g0 + 512); }
                if (rowss) { float ss = (dot4(v00) + dot4(v01)) + (dot4(v10) + dot4(v11)); ss += __shfl_xor(ss, 16); ss += __shfl_xor(ss, 32); if (fq == 0) atomicAdd(rowss + row + fr, ss); }
            }
    }
};

__device__ __forceinline__ void rs_prefetch(const float* rowss, int rowblk, int lane, PG8_LAS unsigned char* xs) {
    const float* src = rowss + rowblk + lane;
    __builtin_amdgcn_global_load_lds((const unsigned*)src, (PG8_LAS unsigned*)xs, 4, 0, 0);
    __builtin_amdgcn_global_load_lds((const unsigned*)(src + HALF), (PG8_LAS unsigned*)(xs + 256), 4, 0, 0);
}
__device__ __forceinline__ float rs_raw(const PG8_LAS unsigned char* xs, int i, int fr) { return ((const PG8_LAS float*)xs)[(i >> 2) * 64 + (i & 3) * 16 + fr]; }
__device__ __forceinline__ void load_rstd(float (&rs)[8], const float* rowss, int row0) {
#pragma unroll
    for (int i = 0; i < 8; ++i) rs[i] = rowss[row0 + (i >> 2) * HALF + (i & 3) * 16];
#pragma unroll
    for (int i = 0; i < 8; ++i) rs[i] = __builtin_amdgcn_rsqf(rs[i] * (1.0f / 1024.0f) + NORM_EPS);
}

__device__ __forceinline__ int dw_perm256(int n) { const int o = n & 255; return (n & ~255) + ((o >> 5) & 1) * 128 + (o >> 6) * 32 + (o & 31); }
__device__ __forceinline__ int dw_drow(int kind, int n) {
    if (kind == 2) return 256 * (n >> 7) + (n & 127);
    if (kind == 3) { if (n < 512) return 256 * (n >> 7) + (n & 127);
        if (n < 1024) { const int n1 = n - 512; return 256 * (n1 >> 7) + 128 + (n1 & 127); }
        if (n < 1536) return dw_perm256(n);
        if (n < 2048) { const int n1 = n - 1536; return 1536 + 256 * (n1 >> 7) + (n1 & 127); }
        const int n1 = n - 2048; return 1536 + 256 * (n1 >> 7) + 128 + (n1 & 127); }
    return dw_perm256(n);
}
constexpr int DW_NMAT = 6, DW_HALF_ITEMS = 2 * (1408 + 1280 + 512 + 1408 + 1408 + 1408);
struct DwTab { const float* W; const float* gain; bf16_t* WT; const void* pad; };
struct DwItem { const float* src; const float* gain; bf16_t* WT; int K, N, kind, radd, k0, n0; };
typedef unsigned u32x8s __attribute__((ext_vector_type(8)));
__device__ __forceinline__ void dw_desc(const DwTab* t, const float*& W, const float*& gain, bf16_t*& WT) {
    const unsigned long long a = (unsigned long long)t; const unsigned lo = __builtin_amdgcn_readfirstlane((unsigned)a), hi = __builtin_amdgcn_readfirstlane((unsigned)(a >> 32));
    const unsigned long long au = ((unsigned long long)hi << 32) | lo; u32x8s r;
    asm volatile("s_load_dwordx8 %0, %1, 0x0\n\ts_waitcnt lgkmcnt(0)" : "=s"(r) : "s"(au) : "memory");
    W = (const float*)(((unsigned long long)r[1] << 32) | r[0]); gain = (const float*)(((unsigned long long)r[3] << 32) | r[2]); WT = (bf16_t*)(((unsigned long long)r[5] << 32) | r[4]);
}
__device__ __forceinline__ DwItem dw_decode(const DwTab* tab, int did) {
    const int h = did & 1; int r = did >> 1, m;
    if (r < 1408) m = 0; else if ((r -= 1408) < 1280) m = 1; else if ((r -= 1280) < 512) m = 2; else if ((r -= 512) < 1408) m = 3; else if ((r -= 1408) < 1408) m = 4; else { r -= 1408; m = 5; }
    DwItem it; it.K = (m == 0 || m == 5) ? 2816 : 1024; it.N = m == 1 ? 2560 : ((m == 3 || m == 4) ? 2816 : 1024); it.kind = m == 1 ? 3 : ((m == 3 || m == 4) ? 2 : 0); it.radd = m == 4 ? 128 : 0;
    int kb, nb;
    if (m == 1) { kb = r / 40; nb = r - 40 * kb; } else if (m == 3 || m == 4) { kb = r / 44; nb = r - 44 * kb; } else { kb = r >> 4; nb = r & 15; }
    it.k0 = 32 * kb + 16 * h; it.n0 = 64 * nb; dw_desc(tab + m, it.src, it.gain, it.WT); return it;
}
__device__ __forceinline__ void dw_load(const DwItem& it, int lane, f32x4 (&wv)[4], float (&wg)[4]) {
    const int n4 = (lane & 15) * 4, kr = lane >> 4;
#pragma unroll
    for (int i = 0; i < 4; ++i) { const int k = it.k0 + 4 * kr + i; wv[i] = __builtin_nontemporal_load((const __attribute__((address_space(1))) f32x4*)(it.src + (size_t)k * it.N + it.n0 + n4)); wg[i] = ((const __attribute__((address_space(1))) float*)it.gain)[k]; }
}
__device__ __forceinline__ void dw_finish(const DwItem& it, int lane, const f32x4 (&wv)[4], const float (&wg)[4], PG8_LAS unsigned char* scr, bool on) {
    const int n4 = (lane & 15) * 4, kr = lane >> 4;
    const f32x4 x0 = wv[0] * wg[0], x1 = wv[1] * wg[1], x2 = wv[2] * wg[2], x3 = wv[3] * wg[3];
#pragma unroll
    for (int c = 0; c < 4; ++c) { u32x2 w; w.x = cvt2(x0[c], x1[c]); w.y = cvt2(x2[c], x3[c]); *(PG8_LAS u32x2*)(scr + (n4 + c) * 32 + kr * 8) = w; }
    asm volatile("" ::: "memory");
    const int kc = lane & 1, nr = lane >> 1;
#pragma unroll
    for (int j = 0; j < 2; ++j) { const int n = nr + 32 * j; const u32x4 o = *(const PG8_LAS u32x4*)(scr + n * 32 + kc * 16);
        const int nd = dw_drow(it.kind, it.n0 + n) + it.radd;
        if (on) *(__attribute__((address_space(1))) u32x4*)(it.WT + img_off((nd & ~31) + invperm32(nd & 31), it.k0 + 8 * kc, it.K >> 6)) = o; }
    asm volatile("" ::: "memory");
}

template <bool DW> struct EpiGUT {
    static constexpr bool PERM = true, AFTER_DRAIN = false;
    __device__ __forceinline__ void prefetch(const Unit& u, int wr, int lane) const { rs_prefetch(rowss, u.pm * BM + wr * 64, lane, xs); }
    const float* rowss; bf16_t* act; int ldc; PG8_LAS unsigned char* xs; const DwTab* dwtab;
    __device__ __forceinline__ void operator()(const f32x4 (&acc)[2][2][4][2], const Unit& u, int wr, int wc, int fr, int fq) const {
        const int lane = fq * 16 + fr, rowg = u.pm * BM + wr * 64, colw = u.pn * HALF + wc * 32;
        const int did = (u.pm * 22 + u.pn) * 8 + wr * 4 + wc; const bool dw = DW && did < DW_HALF_ITEMS;
        DwItem dit; f32x4 wv[4]; float wg[4];
        if constexpr (DW) { dit = dw_decode(dwtab, dw ? did : 0); dw_load(dit, lane, wv, wg); }
        asm volatile("" ::: "memory");
        float msv[8], rsv[8];
#pragma unroll
        for (int i = 0; i < 8; ++i) msv[i] = rs_raw(xs, i, fr) * (1.0f / 1024.0f) + NORM_EPS;
#pragma unroll
        for (int i = 0; i < 8; ++i) rsv[i] = __builtin_amdgcn_rsqf(msv[i]);
        const int ob = fr * 64 + fq * 16, sw = ob ^ (((ob >> 9) & 1) << 5);
        bf16_t* const tile = act + img_off(rowg, colw, ldc >> 6) + (sw >> 1);
#pragma unroll
        for (int ai = 0; ai < 2; ++ai)
#pragma unroll
            for (int m = 0; m < 4; ++m) {
                const int i = ai * 4 + m; const float rs = rsv[i];
                f32x4 o[2]; const float kq = -1.4426950408889634f * rs; const f32x2 ms = {msv[i], msv[i]};
#pragma unroll
                for (int n = 0; n < 2; ++n) { const f32x4 g4 = acc[ai][0][m][n], u4 = acc[ai][1][m][n];
#pragma unroll
                    for (int h = 0; h < 2; ++h) { const f32x2 g = {g4[2 * h], g4[2 * h + 1]}, u = {u4[2 * h], u4[2 * h + 1]};
                        const f32x2 p = g * u, t = g * kq; f32x2 e; e.x = __builtin_amdgcn_exp2f(t.x); e.y = __builtin_amdgcn_exp2f(t.y);
                        const f32x2 d = __builtin_elementwise_fma(e, ms, ms); f32x2 r; r.x = __builtin_amdgcn_rcpf(d.x); r.y = __builtin_amdgcn_rcpf(d.y);
                        const f32x2 q = p * r; o[n][2 * h] = q.x; o[n][2 * h + 1] = q.y; } }
                nt16(pack8(o[0], o[1]), tile + ai * 8192 + m * 1024);
            }
        if constexpr (DW) dw_finish(dit, lane, wv, wg, xs, dw);
    }
};

__device__ __forceinline__ float xchg16(float x) { const unsigned xb = __builtin_bit_cast(unsigned, x); const auto r = __builtin_amdgcn_permlane16_swap(xb, xb, false, false); const unsigned r0 = r[0], r1 = r[1];
    return __builtin_bit_cast(float, r0 ^ r1 ^ xb); }
__device__ __forceinline__ float sum16(float x) { const unsigned xb = __builtin_bit_cast(unsigned, x); const auto r = __builtin_amdgcn_permlane16_swap(xb, xb, false, false); const unsigned r0 = r[0], r1 = r[1];
    return __builtin_bit_cast(float, r0) + __builtin_bit_cast(float, r1); }
__device__ __forceinline__ float sum32(float x) { const unsigned xb = __builtin_bit_cast(unsigned, x); const auto r = __builtin_amdgcn_permlane32_swap(xb, xb, false, false); const unsigned r0 = r[0], r1 = r[1];
    return __builtin_bit_cast(float, r0) + __builtin_bit_cast(float, r1); }
struct EpiIn0 {
    static constexpr bool PERM = true, AFTER_DRAIN = false;
    __device__ __forceinline__ void prefetch(const Unit& u, int wr, int lane) const { rs_prefetch(rowss, u.pm * BM + wr * 64, lane, xs); }
    const float* rowss; bf16_t* UV; bf16_t* Qb; bf16_t* Kb; bf16_t* Vb; const float* qg; const float* kg; const float* rope; PG8_LAS unsigned char* xs;
    __device__ __forceinline__ void operator()(const f32x4 (&acc)[2][2][4][2], const Unit& u, int wr, int wc, int fr_, int fq_) const {
        int lane = fq_ * 16 + fr_; asm volatile("" : "+v"(lane)); const int fr = lane & 15, fq = lane >> 4;
        const int rowg = u.pm * BM + wr * 64, row0 = rowg + fr, pn = u.pn;
        float rsv[8];
#pragma unroll
        for (int i = 0; i < 8; ++i) rsv[i] = __builtin_amdgcn_rsqf(rs_raw(xs, i, fr) * (1.0f / 1024.0f) + NORM_EPS);
        asm volatile("" ::: "memory");
        u32x4 pa, pb;
        if (pn < 4) {
            bf16_t* const tile = UV + kt_off(rowg, pn * BM + wc * 64, 16) + (size_t)(lane >> 3) * 64 + (lane & 7) * 8;
#pragma unroll
            for (int ai = 0; ai < 2; ++ai)
#pragma unroll
                for (int m = 0; m < 4; ++m) {
                    const int i = ai * 4 + m; const float rs = rsv[i]; u32x4 w[2];
#pragma unroll
                    for (int bj = 0; bj < 2; ++bj) { f32x4 v0 = acc[ai][bj][m][0] * rs, v1 = acc[ai][bj][m][1] * rs;
                        const f32x2 a = gelu_pk((f32x2){v0[0], v0[1]}), b = gelu_pk((f32x2){v0[2], v0[3]}), c = gelu_pk((f32x2){v1[0], v1[1]}), d = gelu_pk((f32x2){v1[2], v1[3]});
                        v0 = (f32x4){a.x, a.y, b.x, b.y}; v1 = (f32x4){c.x, c.y, d.x, d.y}; w[bj] = pack8(v0, v1); }
                    if (i > 0) { bf16_t* t0 = tile + (size_t)(((i - 1) >> 2) * HALF + ((i - 1) & 3) * 16) * 64; nt16(pa, t0); nt16(pb, t0 + 8 * 64); }
                    xp_put2(xs, fr, fq, w[0], w[1], pa, pb);
                }
            { bf16_t* t0 = tile + (size_t)(HALF + 3 * 16) * 64; nt16(pa, t0); nt16(pb, t0 + 8 * 64); }
        } else if (pn < 16) {
            const int t = pn - 4, isk = t >= 6 ? 1 : 0, tt = t - 6 * isk, g = tt >> 1, head = 4 * (tt & 1) + wc;
            const int Ra = rowg + (lane >> 3), Rb = Ra + 8, sh = 2 * g;
            bf16_t* const pA = (isk ? Kb : Qb) + hm_off(g, Ra >> 12, head, Ra & 4095) + (lane & 7) * 8; bf16_t* const pB = (isk ? Kb : Qb) + hm_off(g, Rb >> 12, head, Rb & 4095) + (lane & 7) * 8;
            const float osc = isk ? 1.0f : 0.125f * 1.4426950408889634f;
            const float* gp = (isk ? kg : qg) + g * 64 + 8 * fq;
            const f32x4 g00 = *(const f32x4*)(gp) * osc, g01 = *(const f32x4*)(gp + 4) * osc, g10 = *(const f32x4*)(gp + 32) * osc, g11 = *(const f32x4*)(gp + 36) * osc;
            u32x4 rq[4][2];
            const unsigned flip = fq == 0 ? 0x80000000u : 0u;
#pragma unroll
            for (int i = 0; i < 4; ++i) { const int rown = row0 + i * 16; const unsigned* rp = (const unsigned*)rope + (size_t)(fq < 2 ? (rown & 4095) : 4096) * 8; rq[i][0] = *(const u32x4*)(rp); rq[i][1] = *(const u32x4*)(rp + 4); }
            float scv[8]; u32x4 oa[8], ob[8];
#pragma unroll
            for (int i = 0; i < 8; ++i) { const f32x4 a0 = acc[i >> 2][0][i & 3][0], a1 = acc[i >> 2][0][i & 3][1], b0 = acc[i >> 2][1][i & 3][0], b1 = acc[i >> 2][1][i & 3][1];
                f32x2 p = (f32x2){a0[0], a0[1]} * (f32x2){a0[0], a0[1]};
                p = __builtin_elementwise_fma((f32x2){a0[2], a0[3]}, (f32x2){a0[2], a0[3]}, p); p = __builtin_elementwise_fma((f32x2){a1[0], a1[1]}, (f32x2){a1[0], a1[1]}, p); p = __builtin_elementwise_fma((f32x2){a1[2], a1[3]}, (f32x2){a1[2], a1[3]}, p);
                p = __builtin_elementwise_fma((f32x2){b0[0], b0[1]}, (f32x2){b0[0], b0[1]}, p); p = __builtin_elementwise_fma((f32x2){b0[2], b0[3]}, (f32x2){b0[2], b0[3]}, p);
                p = __builtin_elementwise_fma((f32x2){b1[0], b1[1]}, (f32x2){b1[0], b1[1]}, p); p = __builtin_elementwise_fma((f32x2){b1[2], b1[3]}, (f32x2){b1[2], b1[3]}, p);
                scv[i] = p.x + p.y; }
#pragma unroll
            for (int i = 0; i < 8; ++i) scv[i] = sum32(sum16(scv[i]));
#pragma unroll
            for (int i = 0; i < 8; ++i) scv[i] = rsv[i] * __builtin_amdgcn_rsqf(scv[i] * (rsv[i] * rsv[i]) * (1.0f / 64.0f) + NORM_EPS);
#pragma unroll
            for (int ai = 0; ai < 2; ++ai)
#pragma unroll
                for (int m = 0; m < 4; ++m) {
                    const int i = ai * 4 + m;
                    f32x4 a0 = acc[ai][0][m][0], a1 = acc[ai][0][m][1], b0 = acc[ai][1][m][0], b1 = acc[ai][1][m][1];
                    const float sc = scv[i];
                    a0 = a0 * sc * g00; a1 = a1 * sc * g01; b0 = b0 * sc * g10; b1 = b1 * sc * g11;
                    const u32x4 r0 = rq[i & 3][0], r1 = rq[i & 3][1];
                    const unsigned rw[8] = {r0.x, r0.y, r0.z, r0.w, r1.x, r1.y, r1.z, r1.w};
                    const float mine[8] = {a0[0], a0[1], a0[2], a0[3], a1[0], a1[1], a1[2], a1[3]}; f32x2 rot[4];
#pragma unroll
                    for (int e = 0; e < 8; e += 2) { const f32x2 cs = {__builtin_bit_cast(float, rw[e] << 16), __builtin_bit_cast(float, rw[e + 1] << 16)};
                        const f32x2 sn = {__builtin_bit_cast(float, (rw[e] & 0xffff0000u) ^ flip), __builtin_bit_cast(float, (rw[e + 1] & 0xffff0000u) ^ flip)};
                        const f32x2 oth = {xchg16(mine[e]), xchg16(mine[e + 1])}, me = {mine[e], mine[e + 1]};
                        rot[e >> 1] = __builtin_elementwise_fma(oth, sn, me * cs); }
                    a0 = (f32x4){rot[0].x, rot[0].y, rot[1].x, rot[1].y}; a1 = (f32x4){rot[2].x, rot[2].y, rot[3].x, rot[3].y};
                    if (i < 4) { const int rown = row0 + HALF + i * 16; const unsigned* rp = (const unsigned*)rope + (size_t)(fq < 2 ? (rown & 4095) : 4096) * 8; rq[i][0] = *(const u32x4*)(rp); rq[i][1] = *(const u32x4*)(rp + 4); }
                    if (i >= 4 && i < 7) {
#pragma unroll
                        for (int j = 2 * (i - 4); j < 2 * (i - 4) + 2; ++j) { const size_t go = (size_t)((((j >> 2) * HALF + (j & 3) * 16) >> sh) * 64); nt16(oa[j], pA + go); nt16(ob[j], pB + go); } }
                    if (i == 7) { const size_t go = (size_t)(((HALF + 2 * 16) >> sh) * 64); nt16(oa[6], pA + go); nt16(ob[6], pB + go); }
                    xp_put2(xs, fr, fq, pack8(a0, a1), pack8(b0, b1), oa[i], ob[i]);
                }
            { const size_t go = (size_t)(((HALF + 3 * 16) >> sh) * 64); nt16(oa[7], pA + go); nt16(ob[7], pB + go); }
        } else {
            const int g = (pn - 16) >> 1, head = 4 * ((pn - 16) & 1) + wc;
            const int Ra = rowg + (lane >> 3), Rb = Ra + 8, sh = 2 * g;
            bf16_t* const pA = Vb + hm_off(g, Ra >> 12, head, Ra & 4095) + (lane & 7) * 8; bf16_t* const pB = Vb + hm_off(g, Rb >> 12, head, Rb & 4095) + (lane & 7) * 8;
#pragma unroll
            for (int ai = 0; ai < 2; ++ai)
#pragma unroll
                for (int m = 0; m < 4; ++m) {
                    const int i = ai * 4 + m; const float rs = rsv[i];
                    if (i > 0) { const size_t go = (size_t)(((((i - 1) >> 2) * HALF + ((i - 1) & 3) * 16) >> sh) * 64); nt16(pa, pA + go); nt16(pb, pB + go); }
                    xp_put2(xs, fr, fq, pack8(acc[ai][0][m][0] * rs, acc[ai][0][m][1] * rs), pack8(acc[ai][1][m][0] * rs, acc[ai][1][m][1] * rs), pa, pb);
                }
            { const size_t go = (size_t)(((HALF + 3 * 16) >> sh) * 64); nt16(pa, pA + go); nt16(pb, pB + go); }
        }
    }
};

struct EpiIn1 {
    static constexpr bool PERM = true, AFTER_DRAIN = false;
    __device__ __forceinline__ void prefetch(const Unit& u, int wr, int lane) const { rs_prefetch(rowss, u.pm * BM + wr * 64, lane, xs); }
    const float* rowss; bf16_t* P1; PG8_LAS unsigned char* xs;
    __device__ __forceinline__ void operator()(const f32x4 (&acc)[2][2][4][2], const Unit& u, int wr, int wc, int fr, int fq) const {
        const int lane = fq * 16 + fr, rowg = u.pm * BM + wr * 64, pn = u.pn;
        float rsv[8];
#pragma unroll
        for (int i = 0; i < 8; ++i) rsv[i] = __builtin_amdgcn_rsqf(rs_raw(xs, i, fr) * (1.0f / 1024.0f) + NORM_EPS);
        asm volatile("" ::: "memory");
        u32x4 pa, pb;
        if (pn >= 4 && pn < 6) {
            bf16_t* const tile = P1 + kt_off(rowg, 512 + (pn - 4) * BM + wc * 64, 24) + (size_t)(lane >> 3) * 64 + (lane & 7) * 8;
#pragma unroll
            for (int ai = 0; ai < 2; ++ai)
#pragma unroll
                for (int m = 0; m < 4; ++m) {
                    const int i = ai * 4 + m; const float rs = rsv[i];
                    if (i > 0) { bf16_t* t0 = tile + (size_t)(((i - 1) >> 2) * HALF + ((i - 1) & 3) * 16) * 64; nt16(pa, t0); nt16(pb, t0 + 8 * 64); }
                    xp_put2(xs, fr, fq, pack8(acc[ai][0][m][0] * rs, acc[ai][0][m][1] * rs), pack8(acc[ai][1][m][0] * rs, acc[ai][1][m][1] * rs), pa, pb);
                }
            { bf16_t* t0 = tile + (size_t)(HALF + 3 * 16) * 64; nt16(pa, t0); nt16(pb, t0 + 8 * 64); }
        } else {
            const int col = (pn < 4 ? pn * HALF : 1024 + (pn - 6) * HALF) + wc * 32;
            bf16_t* const tile = P1 + kt_off(rowg, col, 24) + (size_t)(lane >> 2) * 64 + (lane & 3) * 8;
#pragma unroll
            for (int ai = 0; ai < 2; ++ai)
#pragma unroll
                for (int m = 0; m < 4; ++m) {
                    const int i = ai * 4 + m; const float rs = rsv[i]; f32x4 o[2];
                    if (pn < 4) {
#pragma unroll
                        for (int n = 0; n < 2; ++n) { const f32x4 a4 = acc[ai][0][m][n], g4 = acc[ai][1][m][n]; const float kq = -1.4426950408889634f * rs, irs1 = __builtin_amdgcn_rcpf(rs); const f32x2 irs = {irs1, irs1};
#pragma unroll
                            for (int h = 0; h < 2; ++h) { const f32x2 a = {a4[2 * h], a4[2 * h + 1]}, g = {g4[2 * h], g4[2 * h + 1]};
                                const f32x2 t = g * kq; f32x2 e; e.x = __builtin_amdgcn_exp2f(t.x); e.y = __builtin_amdgcn_exp2f(t.y);
                                const f32x2 d = __builtin_elementwise_fma(e, irs, irs); f32x2 r; r.x = __builtin_amdgcn_rcpf(d.x); r.y = __builtin_amdgcn_rcpf(d.y);
                                const f32x2 q = a * r; o[n][2 * h] = q.x; o[n][2 * h + 1] = q.y; } }
                    } else {
#pragma unroll
                        for (int n = 0; n < 2; ++n) o[n] = (acc[ai][0][m][n] * rs) * (acc[ai][1][m][n] * rs); }
                    if (i > 0) nt16(pa, tile + (size_t)(((i - 1) >> 2) * HALF + ((i - 1) & 3) * 16) * 64);
                    xp_put1(xs, fr, fq, pack8(o[0], o[1]), pa);
                }
            nt16(pa, tile + (size_t)(HALF + 3 * 16) * 64);
        }
    }
};

}

constexpr int NWAVES = 8;
constexpr int BATCH = 8, SEQ = 4096, DM = 1024, T = BATCH * SEQ;
constexpr int AB_IN = 5632, CD_IN = 2560, DFF = 2816, GU_N = 2 * DFF;
constexpr size_t MiB = 1u << 20;
constexpr size_t WS_CTL = 0, CTL_ZERO_BYTES = 32 * 1024;
constexpr size_t WS_ROPE = 1 * MiB;
constexpr size_t WS_DWTAB = WS_ROPE + 192 * 1024;
constexpr size_t WS_WSG = WS_ROPE + 256 * 1024;
constexpr size_t WS_RSS = WS_WSG + 128 * 1024;
constexpr size_t WS_LSE = 2 * MiB;
constexpr size_t WS_W0IN = 8 * MiB;
constexpr size_t WS_W0OUT = 19 * MiB;
constexpr size_t WS_W0GU = 21 * MiB;
constexpr size_t WS_W0D = 32 * MiB;
constexpr size_t WS_W1IN = 38 * MiB;
constexpr size_t WS_W1OUT = 43 * MiB;
constexpr size_t WS_W1GU = 45 * MiB;
constexpr size_t WS_W1D = 56 * MiB;
constexpr size_t WS_XB = 64 * MiB;
constexpr size_t WS_UV = 128 * MiB;
constexpr size_t WS_Q = 192 * MiB;
constexpr size_t WS_K = 288 * MiB;
constexpr size_t WS_V = 384 * MiB;
constexpr size_t WS_ACT = WS_Q;
constexpr size_t WS_P1 = 368 * MiB;
constexpr size_t WS_AB = WS_K, WS_CD = WS_UV;
constexpr size_t WS_END = 480 * MiB;
constexpr int CW_BAR = 4096;

constexpr int RING_OFF = 0, RING_BYTES = 131072;
constexpr int LDSCTL_OFF = RING_BYTES, MISC_OFF = LDSCTL_OFF + 320;
constexpr int AUX_OFF = LDSCTL_OFF + 1024;
constexpr int XP_OFF = AUX_OFF + 2048;
constexpr int LDS_BYTES = 155648;
static_assert(XP_OFF + 8 * 2304 <= LDS_BYTES, "LDS map");
#define GAS __attribute__((address_space(1)))
#define LAS __attribute__((address_space(3)))
typedef unsigned short bf16;
typedef unsigned v4u __attribute__((ext_vector_type(4)));
typedef float f32x4 __attribute__((ext_vector_type(4)));
typedef short bf16x8 __attribute__((ext_vector_type(8)));
typedef GAS unsigned gu32;
typedef GAS unsigned long long gu64;
#define RLX_AGENT __ATOMIC_RELAXED, __HIP_MEMORY_SCOPE_AGENT
#define LDS_WAIT() asm volatile("s_waitcnt lgkmcnt(0)" ::: "memory")
#define VM_WAIT() asm volatile("s_waitcnt vmcnt(0)" ::: "memory")
__device__ __forceinline__ unsigned long long rt() { return __builtin_amdgcn_s_memrealtime(); }
__device__ __forceinline__ unsigned f2bf(float f) { unsigned u = __builtin_bit_cast(unsigned, f); return (u + 0x7fffu + ((u >> 16) & 1u)) >> 16; }
__device__ __forceinline__ unsigned pk2(float lo, float hi) { return f2bf(lo) | (f2bf(hi) << 16); }

#define XB_TMO      128
#define XB_XCNT(j)  (256  + 64 * (j))
#define XB_XSUB(j)  (1280 + 64 * (j))
#define XB_XGEN(j)  (2304 + 64 * (j))
#define XB_TOP      3328
#define XB_TOPGEN   3392
#define XCD_BAR_WORDS 3456
#define XB_SPIN_CAP (1u << 18)

__device__ __forceinline__ unsigned xb_ld(unsigned* p)              { return __hip_atomic_load(p, __ATOMIC_RELAXED, __HIP_MEMORY_SCOPE_AGENT); }
__device__ __forceinline__ unsigned xb_add(unsigned* p, unsigned v) { return __hip_atomic_fetch_add(p, v, __ATOMIC_RELAXED, __HIP_MEMORY_SCOPE_AGENT); }
__device__ __forceinline__ unsigned xb_xcc_id() { return (unsigned)__builtin_amdgcn_s_getreg((3 << 11) | 20) & 0xFu; }
#define XB_SPIN(cond, bar) do { unsigned _sp = 0; while (cond) { __builtin_amdgcn_s_sleep(1); \
    if ((++_sp & 255u) == 0u) { if (xb_ld(&(bar)[XB_TMO])) break; if (_sp > XB_SPIN_CAP) { atomicAdd(&(bar)[XB_TMO], 1u); break; } } } } while (0)

struct XcdBarrier {
    unsigned* bar; unsigned x;
    volatile LAS unsigned* st;
};

__device__ __forceinline__ XcdBarrier xcd_barrier_post(unsigned* bar, volatile LAS unsigned* st) {
    XcdBarrier b; b.bar = bar; b.x = xb_xcc_id(); b.st = st;
    if (threadIdx.x == 0) (void)xb_add(&bar[XB_XCNT(b.x)], 1u);
    return b;
}
__device__ __forceinline__ void xcd_barrier_complete(unsigned* bar, unsigned x, unsigned& nloc, unsigned& nx) {
    const unsigned G = gridDim.x * gridDim.y * gridDim.z;
    unsigned sum, cnt, mine, sp = 0u;
    for (;;) {
        sum = 0u; cnt = 0u; mine = 0u;
#pragma unroll
        for (unsigned j = 0; j < 16; ++j) { const unsigned c = xb_ld(&bar[XB_XCNT(j)]); sum += c; cnt += (c > 0u) ? 1u : 0u; mine = (j == x) ? c : mine; }
        if (sum == G) break;
        __builtin_amdgcn_s_sleep(1);
        if ((++sp & 255u) == 0u) { if (xb_ld(&bar[XB_TMO])) break; if (sp > XB_SPIN_CAP) { atomicAdd(&bar[XB_TMO], 1u); break; } }
    }
    nloc = mine > 0u ? mine : 1u; nx = cnt > 0u ? cnt : 1u;
}

__device__ __forceinline__ void xcd_barrier(const XcdBarrier& b) {
    asm volatile("s_waitcnt vmcnt(0)" ::: "memory");
    __syncthreads();
    if (threadIdx.x == 0) {
        unsigned* bar = b.bar;
        __builtin_amdgcn_s_waitcnt(0);
        unsigned nloc = b.st[0], nx = b.st[1];
        if (nloc == 0u) { xcd_barrier_complete(bar, b.x, nloc, nx); b.st[0] = nloc; b.st[1] = nx; }
        const unsigned old = xb_add(&bar[XB_XSUB(b.x)], 1u);
        const unsigned gen = old / nloc;
        if (old + 1u == (gen + 1u) * nloc) {
            __builtin_amdgcn_fence(__ATOMIC_RELEASE, "agent");
            asm volatile("s_waitcnt vmcnt(0)" ::: "memory");
            const unsigned og = xb_add(&bar[XB_TOP], 1u);
            const unsigned tg = og / nx;
            if (og + 1u == (tg + 1u) * nx) xb_add(&bar[XB_TOPGEN], 1u);
            else XB_SPIN(xb_ld(&bar[XB_TOPGEN]) == tg, bar);
            __builtin_amdgcn_fence(__ATOMIC_ACQUIRE, "agent");
            xb_add(&bar[XB_XGEN(b.x)], 1u);
            asm volatile("s_waitcnt vmcnt(0)" ::: "memory");
        } else {
            XB_SPIN(xb_ld(&bar[XB_XGEN(b.x)]) == gen, bar);
            __builtin_amdgcn_fence(__ATOMIC_ACQUIRE, "agent");
            asm volatile("s_waitcnt vmcnt(0)" ::: "memory");
        }
    }
    __syncthreads();
}

typedef unsigned u32x2 __attribute__((ext_vector_type(2)));
typedef float f32x16 __attribute__((ext_vector_type(16)));
typedef short s16x4 __attribute__((ext_vector_type(4)));
struct Frame {
    LAS unsigned char* lds;
    volatile LAS unsigned* MISC;
    gu32* ctl;
    int wave;
    int vcu, G;
    const float* in[22];
    float* out;
    unsigned char* ws;
};
__device__ __forceinline__ float wave_sum(float v) {
#pragma unroll
    for (int o = 1; o < 64; o <<= 1) v += __shfl_xor(v, o);
    return v;
}
__device__ __forceinline__ int red16_idx(int lane) { return ((lane >> 5) & 1) * 8 + ((lane >> 4) & 1) * 4 + ((lane >> 3) & 1) * 2 + ((lane >> 2) & 1); }
template <int H, int MSK> __device__ __forceinline__ void red16_step(float (&v)[16], int lane) { const bool up = (lane & MSK) != 0;
#pragma unroll
    for (int i = 0; i < H; ++i) { const float send = up ? v[i] : v[i + H], keep = up ? v[i + H] : v[i]; v[i] = keep + __shfl_xor(send, MSK); } }
__device__ __forceinline__ void reduce16(float (&v)[16], int lane) {
    red16_step<8, 32>(v, lane); red16_step<4, 16>(v, lane); red16_step<2, 8>(v, lane); red16_step<1, 4>(v, lane);
    v[0] += __shfl_xor(v[0], 2); v[0] += __shfl_xor(v[0], 1);
}
__device__ __forceinline__ unsigned cvtpk_s(float lo, float hi) { typedef float f2_t __attribute__((ext_vector_type(2))); typedef __bf16 b2_t __attribute__((ext_vector_type(2)));
    f2_t v = {lo, hi}; b2_t b = __builtin_convertvector(v, b2_t); return __builtin_bit_cast(unsigned, b); }
__device__ __forceinline__ float bf_lo(unsigned w) { return __builtin_bit_cast(float, w << 16); }
__device__ __forceinline__ float bf_hi(unsigned w) { return __builtin_bit_cast(float, w & 0xffff0000u); }

__device__ __forceinline__ int p0_perm256(int n) { const int o = n & 255; return (n & ~255) + ((o >> 5) & 1) * 128 + (o >> 6) * 32 + (o & 31); }
__device__ __forceinline__ int p0_drow(int kind, int n) {
    if (kind == 2) return 256 * (n >> 7) + (n & 127);
    if (kind == 3) { if (n < 512) return 256 * (n >> 7) + (n & 127);
        if (n < 1024) { const int n1 = n - 512; return 256 * (n1 >> 7) + 128 + (n1 & 127); }
        if (n < 1536) return p0_perm256(n);
        if (n < 2048) { const int n1 = n - 1536; return 1536 + 256 * (n1 >> 7) + (n1 & 127); }
        const int n1 = n - 2048; return 1536 + 256 * (n1 >> 7) + 128 + (n1 & 127); }
    return p0_perm256(n);
}
__device__ __forceinline__ void p0_item(const float* W, int K, int N, int k0, int n0, bf16* WT, int kind, int radd, const float* gain, LAS unsigned char* scr, int lane) {
    const int n4 = (lane & 15) * 4, kr = lane >> 4;
    f32x4 v[16]; float gv[16];
#pragma unroll
    for (int i = 0; i < 16; ++i) { v[i] = __builtin_nontemporal_load((const GAS f32x4*)(W + (size_t)(k0 + 4 * i + kr) * N + n0 + n4)); gv[i] = gain ? gain[k0 + 4 * i + kr] : 1.0f; }
#pragma unroll
    for (int i = 0; i < 16; ++i) { const f32x4 x = v[i] * gv[i]; LAS unsigned* d = (LAS unsigned*)(scr + (4 * i + kr) * 132 + n4 * 2); d[0] = pk2(x.x, x.y); d[1] = pk2(x.z, x.w); }
    LDS_WAIT(); asm volatile("" ::: "memory");
    const int kc = lane & 7, nr = lane >> 3;
#pragma unroll
    for (int j = 0; j < 8; ++j) { const int n = nr + 8 * j; const LAS unsigned short* sp = (const LAS unsigned short*)(scr + (8 * kc) * 132 + n * 2);
        v4u o; o.x = (unsigned)sp[0] | ((unsigned)sp[66] << 16); o.y = (unsigned)sp[132] | ((unsigned)sp[198] << 16); o.z = (unsigned)sp[264] | ((unsigned)sp[330] << 16); o.w = (unsigned)sp[396] | ((unsigned)sp[462] << 16);
        const int nd = p0_drow(kind, n0 + n) + radd;
        *(GAS v4u*)(WT + pg8::img_off((nd & ~31) + pg8::invperm32(nd & 31), k0 + 8 * kc, K >> 6)) = o; }
    LDS_WAIT(); asm volatile("" ::: "memory");
}
__device__ __forceinline__ void p0_prologue(Frame& F) {
    LAS unsigned char* scr = F.lds + RING_OFF + F.wave * 16384;
    const int lane = mk_lane_id(); const int gw = F.vcu * NWAVES + F.wave, NGW = F.G * NWAVES;
    unsigned char* ws = F.ws;
    constexpr int I_IN0 = 16 * (AB_IN / 64), I_SQ = 16 * 16, I_GU = 16 * (DFF / 64), I_DN = (DFF / 64) * 16, I_IN1 = 16 * (CD_IN / 64);
    constexpr int NITEMS = I_IN0 + I_SQ + 2 * I_GU;
    for (int it = gw; it < NITEMS; it += NGW) {
        int r = it;
        if (r < I_IN0) { const int nblk = AB_IN / 64; p0_item(F.in[2], 1024, AB_IN, 64 * (r / nblk), 64 * (r % nblk), (bf16*)(ws + WS_W0IN), 1, 0, F.in[1], scr, lane); continue; }
        r -= I_IN0;
        if (r < I_SQ) { p0_item(F.in[9], 1024, 1024, 64 * (r / 16), 64 * (r % 16), (bf16*)(ws + WS_W0OUT), 0, 0, nullptr, scr, lane); continue; }
        r -= I_SQ;
        if (r < 2 * I_GU) { const int up = r >= I_GU ? 1 : 0; r -= up * I_GU; const int nblk = DFF / 64;
            p0_item(F.in[up ? 20 : 19], 1024, DFF, 64 * (r / nblk), 64 * (r % nblk), (bf16*)(ws + WS_W0GU), 2, 128 * up, F.in[18], scr, lane); continue; }
    }
    if (gw == 0 && lane == 0) {
        pg8::DwTab* tab = (pg8::DwTab*)(ws + WS_DWTAB); const float* ones = (const float*)(ws + WS_DWTAB + 4096);
        tab[0] = pg8::DwTab{F.in[21], ones, (bf16*)(ws + WS_W0D), nullptr};
        tab[1] = pg8::DwTab{F.in[11], F.in[10], (bf16*)(ws + WS_W1IN), nullptr};
        tab[2] = pg8::DwTab{F.in[17], ones, (bf16*)(ws + WS_W1OUT), nullptr};
        tab[3] = pg8::DwTab{F.in[19] + (size_t)1024 * DFF, F.in[18] + 1024, (bf16*)(ws + WS_W1GU), nullptr};
        tab[4] = pg8::DwTab{F.in[20] + (size_t)1024 * DFF, F.in[18] + 1024, (bf16*)(ws + WS_W1GU), nullptr};
        tab[5] = pg8::DwTab{F.in[21] + (size_t)DFF * 1024, ones, (bf16*)(ws + WS_W1D), nullptr};
    }
    float* rss = (float*)(ws + WS_RSS); bf16* XB = (bf16*)(ws + WS_XB);
    for (int m0 = gw * 16; m0 < T; m0 += NGW * 16) {
        const int fr = lane & 15, fq = lane >> 4, ob = fr * 64 + fq * 16, sw = ob ^ (((ob >> 9) & 1) << 5);
        const GAS f32x4* xr = (const GAS f32x4*)(F.in[0] + (size_t)(m0 + fr) * DM + fq * 8);
        bf16* const xo = XB + pg8::img_off(m0, 0, 16) + (sw >> 1);
        float ss = 0.f;
#pragma unroll
        for (int cb = 0; cb < 4; ++cb) {
            f32x4 v[8][2];
#pragma unroll
            for (int c = 0; c < 8; ++c) { v[c][0] = __builtin_nontemporal_load(xr + (cb * 8 + c) * 8); v[c][1] = __builtin_nontemporal_load(xr + (cb * 8 + c) * 8 + 1); }
#pragma unroll
            for (int c = 0; c < 8; ++c) { const f32x4 a = v[c][0], b2 = v[c][1]; const int cg = cb * 8 + c;
                ss += ((a.x * a.x + a.y * a.y) + (a.z * a.z + a.w * a.w)) + ((b2.x * b2.x + b2.y * b2.y) + (b2.z * b2.z + b2.w * b2.w));
                v4u o; o.x = pk2(a.x, a.y); o.y = pk2(a.z, a.w); o.z = pk2(b2.x, b2.y); o.w = pk2(b2.z, b2.w);
                *(GAS v4u*)(xo + (cg >> 1) * 16384 + (cg & 1) * 512) = o; }
        }
        ss += __shfl_xor(ss, 16); ss += __shfl_xor(ss, 32);
        if (fq == 0) rss[m0 + fr] = ss;
    }
    const int gt = gw * 64 + lane, NGT = NGW * 64;
    for (int i = gt; i < DFF; i += NGT) ((float*)(ws + WS_DWTAB + 4096))[i] = 1.0f;
    for (int i = gt; i < 3 * T; i += NGT) rss[T + i] = 0.f;
    float* rope = (float*)(ws + WS_ROPE);
    for (int i = gt; i < SEQ * 8 + 8; i += NGT) { const int pos = i >> 3, k = i & 7; const float inv = exp2f(-2.3664460711655218f * (float)k), ang = (float)pos * inv;
        ((unsigned*)rope)[i] = pos < SEQ ? pk2(cosf(ang), sinf(ang)) : 0x00003f80u; }
    bf16* wsg = (bf16*)(ws + WS_WSG); const float* sw = F.in[5];
    for (int i = gt; i < 4 * 128 * 128; i += NGT) { const int g = i >> 14, t = (i >> 7) & 127, s = i & 127;
        wsg[((((g * 4 + (t >> 5)) * 8 + (s >> 4)) * 64 + ((s >> 3) & 1) * 32 + (t & 31)) << 3) + (s & 7)] = (bf16)(s <= t ? f2bf(sw[i]) : 0u); }
}

namespace att {
constexpr int KCH = 6160, LDS_KO = 0, LDS_VO = 8 * KCH, NUNITS = 3 * BATCH * 8 * 16;
__device__ __forceinline__ s16x4 vtr(const LAS unsigned char* p) { return __builtin_bit_cast(s16x4, __builtin_amdgcn_ds_read_tr16_b64_v4i16((LAS s16x4*)p)); }
struct UnitAddr { int g, h, sh, qb, rowb, j0; size_t hb; };
__device__ __forceinline__ UnitAddr decode(int U) { UnitAddr a; a.g = U >> 10; const int rem = U & 1023, b = rem >> 7, cq = rem & 15; a.h = (rem >> 4) & 7;
    a.sh = 2 * a.g; const int nbs = 4 - a.sh, c = cq >> nbs; a.qb = cq & ((1 << nbs) - 1); a.j0 = 256 * a.qb - 128; a.rowb = b * SEQ + c; a.hb = ((size_t)((((a.g * 8 + b) * 8 + a.h) << 12) + (c << (12 - a.sh)))) * 64; return a; }
__device__ __forceinline__ void attn_load(int U, bool chained, const bf16* Qb, const bf16* Kb, const bf16* Vb, v4u (&kv)[6], v4u (&vv)[6], bf16x8 (&qr)[4], int tid, int wid, int lane) {
    const UnitAddr a = decode(U);
#pragma unroll
    for (int i = 0; i < 6; ++i) { const int idx = i * 512 + tid, key = idx >> 3, ch = idx & 7, j = a.j0 + key;
        kv[i] = (v4u){0u, 0u, 0u, 0u}; vv[i] = (v4u){0u, 0u, 0u, 0u};
        if (j >= 0 && !(chained && i < 2)) {
            const size_t off = a.hb + (size_t)j * 64 + ch * 8; kv[i] = __builtin_nontemporal_load((const GAS v4u*)(Kb + off)); vv[i] = __builtin_nontemporal_load((const GAS v4u*)(Vb + off)); } }
    const size_t qoff = a.hb + (size_t)(256 * a.qb + 32 * wid + (lane >> 3)) * 64 + (lane & 7) * 8;
#pragma unroll
    for (int k = 0; k < 4; ++k) qr[k] = __builtin_nontemporal_load((const GAS bf16x8*)(Qb + qoff + (size_t)k * 8 * 64));
}
__device__ __forceinline__ LAS unsigned char* wave_scr(LAS unsigned char* lds, int wid) { return lds + (wid < 7 ? LDS_VO + 49152 + wid * 4096 : XP_OFF); }
__device__ __forceinline__ void q_frags(LAS unsigned char* scr, const bf16x8 (&qn)[4], bf16x8 (&qr)[4], int lane) {
    const int r32 = lane & 31, hi = lane >> 5;
#pragma unroll
    for (int k = 0; k < 4; ++k) { const int row = 8 * k + (lane >> 3); *(LAS bf16x8*)(scr + row * 128 + (((lane & 7) ^ (row & 7)) << 4)) = qn[k]; }
#pragma unroll
    for (int d0 = 0; d0 < 4; ++d0) qr[d0] = *(const LAS bf16x8*)(scr + r32 * 128 + (((2 * d0 + hi) ^ (r32 & 7)) << 4));
}
__device__ __forceinline__ void attn_stage(LAS unsigned char* lds, int qb, bool chained, const v4u (&kv)[6], const v4u (&vv)[6], int tid) {
    const int rb = (256 * qb) % 384;
#pragma unroll
    for (int i = 0; i < 6; ++i) { if (chained && i < 2) continue;
        const int idx = i * 512 + tid, ch = idx & 7; int key = rb + (idx >> 3); if (key >= 384) key -= 384;
        *(LAS v4u*)(lds + LDS_KO + ch * KCH + key * 16) = kv[i];
        *(LAS v4u*)(lds + LDS_VO + ((key >> 3) * 2 + (ch >> 2)) * 512 + (key & 7) * 64 + (ch & 3) * 16) = vv[i]; }
}
struct AttnNoMid { __device__ __forceinline__ void operator()() const {} };
template <class Mid = AttnNoMid> __device__ __forceinline__ void attn_compute(LAS unsigned char* lds, int U, const bf16x8 (&qr)[4], bf16* Ob, float* LSE, int wid, int lane, Mid&& mid = AttnNoMid()) {
    const UnitAddr a = decode(U); const int qb = a.qb;
    const int r32 = lane & 31, hi = lane >> 5;
    const size_t qrow = (size_t)(a.rowb + ((256 * qb + 32 * wid + r32) << a.sh));
    const int tb0 = ((8 * qb) % 12 + wid) % 12;
    f32x16 p[5];
#pragma unroll
    for (int kt = 0; kt < 5; ++kt) {
        const bool ex = (qb > 0) || (wid + kt >= 4);
        const int ts = (tb0 + kt >= 12) ? tb0 + kt - 12 : tb0 + kt;
        if (ex) { f32x16 acc = {}; const LAS unsigned char* kp = lds + LDS_KO + hi * KCH + (32 * ts + r32) * 16;
#pragma unroll
            for (int d0 = 0; d0 < 4; ++d0) acc = __builtin_amdgcn_mfma_f32_32x32x16_bf16(*(const LAS bf16x8*)(kp + d0 * 2 * KCH), qr[d0], acc, 0, 0, 0);
            p[kt] = acc;
        } else {
#pragma unroll
            for (int r = 0; r < 16; ++r) p[kt][r] = -INFINITY; }
    }
#pragma unroll
    for (int r = 0; r < 16; ++r) { const int cr = (r & 3) + 8 * (r >> 2) + 4 * hi; if (cr < r32) p[0][r] = -INFINITY; if (cr > r32) p[4][r] = -INFINITY; }
    float m = -INFINITY;
#pragma unroll
    for (int kt = 0; kt < 5; ++kt)
#pragma unroll
        for (int r = 0; r < 16; ++r) m = fmaxf(m, p[kt][r]);
    m = fmaxf(m, __shfl_xor(m, 32));
    mid();
    float l = 0.f;
    f32x16 o0 = {}, o1 = {};
    const int gi = lane >> 4, q_ = (lane & 15) >> 2, p_ = lane & 3;
    const LAS unsigned char* vbase = lds + LDS_VO + (4 * hi + q_) * 64 + (gi & 1) * 32 + p_ * 8;
    const int ts4 = (tb0 + 4 >= 12) ? tb0 + 4 - 12 : tb0 + 4;
#pragma unroll
    for (int kt = 0; kt < 5; ++kt) {
        const bool ex = (qb > 0) || (wid + kt >= 4);
        const int ts = ex ? ((tb0 + kt >= 12) ? tb0 + kt - 12 : tb0 + kt) : ts4;
#pragma unroll
        for (int r = 0; r < 16; ++r) { p[kt][r] = __builtin_amdgcn_exp2f(p[kt][r] - m); l += p[kt][r]; }
        {
#pragma unroll
            for (int s = 0; s < 2; ++s) {
                v4u pw; pw.x = cvtpk_s(p[kt][8 * s + 0], p[kt][8 * s + 1]); pw.y = cvtpk_s(p[kt][8 * s + 2], p[kt][8 * s + 3]); pw.z = cvtpk_s(p[kt][8 * s + 4], p[kt][8 * s + 5]); pw.w = cvtpk_s(p[kt][8 * s + 6], p[kt][8 * s + 7]);
                const bf16x8 pb = __builtin_bit_cast(bf16x8, pw);
                const LAS unsigned char* vp = vbase + (4 * ts + 2 * s) * 1024;
                const s16x4 a00 = vtr(vp), a01 = vtr(vp + 1024), a10 = vtr(vp + 512), a11 = vtr(vp + 1536);
                const bf16x8 A0 = (bf16x8){a00[0], a00[1], a00[2], a00[3], a01[0], a01[1], a01[2], a01[3]}, A1 = (bf16x8){a10[0], a10[1], a10[2], a10[3], a11[0], a11[1], a11[2], a11[3]};
                o0 = __builtin_amdgcn_mfma_f32_32x32x16_bf16(A0, pb, o0, 0, 0, 0); o1 = __builtin_amdgcn_mfma_f32_32x32x16_bf16(A1, pb, o1, 0, 0, 0);
            }
        }
    }
    l += __shfl_xor(l, 32);
    const float inv = 1.0f / l;
    LAS unsigned char* scr = wave_scr(lds, wid);
#pragma unroll
    for (int rg = 0; rg < 4; ++rg) {
        u32x2 w0, w1; w0.x = cvtpk_s(o0[4 * rg] * inv, o0[4 * rg + 1] * inv); w0.y = cvtpk_s(o0[4 * rg + 2] * inv, o0[4 * rg + 3] * inv);
        w1.x = cvtpk_s(o1[4 * rg] * inv, o1[4 * rg + 1] * inv); w1.y = cvtpk_s(o1[4 * rg + 2] * inv, o1[4 * rg + 3] * inv);
        *(LAS u32x2*)(scr + r32 * 128 + ((rg ^ (r32 & 7)) << 4) + 8 * hi) = w0; *(LAS u32x2*)(scr + r32 * 128 + (((4 + rg) ^ (r32 & 7)) << 4) + 8 * hi) = w1; }
    bf16* op = Ob + a.hb + (size_t)(256 * qb + 32 * wid + (lane >> 3)) * 64 + (lane & 7) * 8;
#pragma unroll
    for (int k = 0; k < 4; ++k) { const int row = 8 * k + (lane >> 3); const v4u v = *(const LAS v4u*)(scr + row * 128 + (((lane & 7) ^ (row & 7)) << 4)); *(GAS v4u*)(op + (size_t)k * 8 * 64) = v; }
    if (hi == 0) LSE[((size_t)a.g * T + qrow) * 8 + a.h] = m + __builtin_amdgcn_logf(l);
}
__device__ __forceinline__ void attn_phase(LAS unsigned char* lds, int vcu, int G, const bf16* Qb, const bf16* Kb, const bf16* Vb, bf16* Ob, float* LSE, int wid) {
    int lane = mk_lane_id(); asm volatile("" : "+v"(lane)); const int tid = wid * 64 + lane;
    v4u kv[6], vv[6]; bf16x8 qn[4], qr[4];
    if (G == 256) {
        attn_load(4 * vcu, false, Qb, Kb, Vb, kv, vv, qn, tid, wid, lane);
        for (int s = 0; s < 12; ++s) { const int U = (s >> 2) * 1024 + 4 * vcu + (s & 3); const bool chained = (s < 8) && ((s & 3) != 0);
            attn_stage(lds, decode(U).qb, chained, kv, vv, tid);
            q_frags(wave_scr(lds, wid), qn, qr, lane);
            __syncthreads();
            auto ld = [&]() __attribute__((always_inline)) { if (s + 1 < 12) { const int Un = ((s + 1) >> 2) * 1024 + 4 * vcu + ((s + 1) & 3); attn_load(Un, (s + 1 < 8) && (((s + 1) & 3) != 0), Qb, Kb, Vb, kv, vv, qn, tid, wid, lane); } };
            if (wid >= 4) ld();
            attn_compute(lds, U, qr, Ob, LSE, wid, lane, [&]() __attribute__((always_inline)) { if (wid < 4) ld(); });
            __syncthreads();
        }
        return;
    }
    if (vcu >= NUNITS) return;
    attn_load(vcu, false, Qb, Kb, Vb, kv, vv, qn, tid, wid, lane);
    for (int U = vcu; U < NUNITS; U += G) {
        attn_stage(lds, decode(U).qb, false, kv, vv, tid);
        q_frags(wave_scr(lds, wid), qn, qr, lane);
        __syncthreads();
        if (U + G < NUNITS) attn_load(U + G, false, Qb, Kb, Vb, kv, vv, qn, tid, wid, lane);
        attn_compute(lds, U, qr, Ob, LSE, wid, lane);
        __syncthreads();
    }
}
}

__device__ __forceinline__ void sg_unit(Frame& F, int unit) {
    LAS unsigned char* lds = F.lds; int lane = mk_lane_id(); asm volatile("" : "+v"(lane)); const int wid = F.wave, tid = wid * 64 + lane;
    const int row0 = unit * 128;
    const bf16* UV = (const bf16*)(F.ws + WS_UV); bf16* AB = (bf16*)(F.ws + WS_AB); const bf16* OG = (const bf16*)(F.ws + WS_Q); const float* LSE = (const float*)(F.ws + WS_LSE);
    const bf16* wsg = (const bf16*)(F.ws + WS_WSG);
    v4u uu[16];
    LAS f32x4* wts = (LAS f32x4*)(lds + XP_OFF);
    {
        v4u raw[16]; float sm[16], sq[16];
#pragma unroll
        for (int tk = 0; tk < 16; ++tk) raw[tk] = __builtin_nontemporal_load((const GAS v4u*)(UV + pg8::kt_off(row0 + wid * 16 + tk, 512 + 8 * lane, 16)));
        float l0[2], l1[2], l2[2];
#pragma unroll
        for (int q = 0; q < 2; ++q) { const int pr = q * 512 + tid; const size_t row = (size_t)(row0 + (pr >> 3)); const int head = pr & 7;
            l0[q] = LSE[row * 8 + head]; l1[q] = LSE[((size_t)T + row) * 8 + head]; l2[q] = LSE[((size_t)2 * T + row) * 8 + head]; }
#pragma unroll
        for (int q = 0; q < 8; ++q) { const int idx = q * 512 + tid, t = idx >> 6, chunk = idx & 63; uu[q] = __builtin_nontemporal_load((const GAS v4u*)(UV + pg8::kt_off(row0 + t, chunk * 8, 16))); }
        const f32x4 ga = *(const f32x4*)(F.in[3] + 8 * lane), gb = *(const f32x4*)(F.in[3] + 8 * lane + 4), ba = *(const f32x4*)(F.in[4] + 8 * lane), bb = *(const f32x4*)(F.in[4] + 8 * lane + 4);
#pragma unroll
        for (int tk = 0; tk < 16; ++tk) { const float x0 = bf_lo(raw[tk].x), x1 = bf_hi(raw[tk].x), x2 = bf_lo(raw[tk].y), x3 = bf_hi(raw[tk].y), x4 = bf_lo(raw[tk].z), x5 = bf_hi(raw[tk].z), x6 = bf_lo(raw[tk].w), x7 = bf_hi(raw[tk].w);
            sm[tk] = ((x0 + x1) + (x2 + x3)) + ((x4 + x5) + (x6 + x7)); sq[tk] = ((x0 * x0 + x1 * x1) + (x2 * x2 + x3 * x3)) + ((x4 * x4 + x5 * x5) + (x6 * x6 + x7 * x7)); }
        reduce16(sm, lane); reduce16(sq, lane);
        LAS float* st = (LAS float*)(lds + AUX_OFF) + wid * 32;
        { const float mean = sm[0] * (1.0f / 512.0f), var = fmaxf(sq[0] * (1.0f / 512.0f) - mean * mean, 0.f);
          if ((lane & 3) == 0) { st[2 * red16_idx(lane)] = mean; st[2 * red16_idx(lane) + 1] = __builtin_amdgcn_rsqf(var + 1e-6f); } }
#pragma unroll
        for (int tk = 0; tk < 16; ++tk) { const int s = wid * 16 + tk; const float mean = st[2 * tk], rstd = st[2 * tk + 1];
            const float x0 = bf_lo(raw[tk].x) - mean, x1 = bf_hi(raw[tk].x) - mean, x2 = bf_lo(raw[tk].y) - mean, x3 = bf_hi(raw[tk].y) - mean, x4 = bf_lo(raw[tk].z) - mean, x5 = bf_hi(raw[tk].z) - mean, x6 = bf_lo(raw[tk].w) - mean, x7 = bf_hi(raw[tk].w) - mean;
            v4u o; o.x = cvtpk_s(x0 * rstd * ga[0] + ba[0], x1 * rstd * ga[1] + ba[1]); o.y = cvtpk_s(x2 * rstd * ga[2] + ba[2], x3 * rstd * ga[3] + ba[3]);
            o.z = cvtpk_s(x4 * rstd * gb[0] + bb[0], x5 * rstd * gb[1] + bb[1]); o.w = cvtpk_s(x6 * rstd * gb[2] + bb[2], x7 * rstd * gb[3] + bb[3]);
            *(LAS v4u*)(lds + ((s >> 3) * 16 + (lane >> 2)) * 512 + (s & 7) * 64 + (lane & 3) * 16) = o; }
#pragma unroll
        for (int q = 0; q < 2; ++q) { const int pr = q * 512 + tid;
            const float mx = fmaxf(l0[q], fmaxf(l1[q], l2[q])); const float w0 = __builtin_amdgcn_exp2f(l0[q] - mx), w1 = __builtin_amdgcn_exp2f(l1[q] - mx), w2 = __builtin_amdgcn_exp2f(l2[q] - mx);
            const float iv = 1.0f / (w0 + w1 + w2); wts[pr] = (f32x4){w0 * iv, w1 * iv, w2 * iv, 0.f}; }
    }
    __syncthreads();
    v4u ma[8], mb[8], mc[8];
#define SG_MLOAD(H, TID) _Pragma("unroll") for (int q = 0; q < 8; ++q) { const int idx = ((H) * 8 + q) * 512 + (TID), tk = idx >> 6, pc = idx & 63, head = pc >> 3; const size_t row = (size_t)(row0 + tk); \
        const int bb_ = (int)(row >> 12), tt_ = (int)(row & 4095), dd = (pc & 7) * 8; \
        ma[q] = __builtin_nontemporal_load((const GAS v4u*)(OG + pg8::hm_off(0, bb_, head, tt_) + dd)); mb[q] = __builtin_nontemporal_load((const GAS v4u*)(OG + pg8::hm_off(1, bb_, head, tt_) + dd)); \
        mc[q] = __builtin_nontemporal_load((const GAS v4u*)(OG + pg8::hm_off(2, bb_, head, tt_) + dd)); }
#define SG_MERGE(H, TID) _Pragma("unroll") for (int q = 0; q < 8; ++q) { const int idx = ((H) * 8 + q) * 512 + (TID), tk = idx >> 6, pc = idx & 63; const size_t row = (size_t)(row0 + tk); \
        const f32x4 w = wts[tk * 8 + (pc >> 3)]; const float w0 = w[0], w1 = w[1], w2 = w[2]; \
        v4u o; \
        o.x = cvtpk_s(w0 * bf_lo(ma[q].x) + w1 * bf_lo(mb[q].x) + w2 * bf_lo(mc[q].x), w0 * bf_hi(ma[q].x) + w1 * bf_hi(mb[q].x) + w2 * bf_hi(mc[q].x)); \
        o.y = cvtpk_s(w0 * bf_lo(ma[q].y) + w1 * bf_lo(mb[q].y) + w2 * bf_lo(mc[q].y), w0 * bf_hi(ma[q].y) + w1 * bf_hi(mb[q].y) + w2 * bf_hi(mc[q].y)); \
        o.z = cvtpk_s(w0 * bf_lo(ma[q].z) + w1 * bf_lo(mb[q].z) + w2 * bf_lo(mc[q].z), w0 * bf_hi(ma[q].z) + w1 * bf_hi(mb[q].z) + w2 * bf_hi(mc[q].z)); \
        o.w = cvtpk_s(w0 * bf_lo(ma[q].w) + w1 * bf_lo(mb[q].w) + w2 * bf_lo(mc[q].w), w0 * bf_hi(ma[q].w) + w1 * bf_hi(mb[q].w) + w2 * bf_hi(mc[q].w)); \
        *(GAS v4u*)(AB + pg8::img_off((int)row, 512 + pc * 8, 16)) = o; }
    {
        int lb_ = lane; asm volatile("" : "+v"(lb_));
        const int r32 = lb_ & 31, hi = lb_ >> 5, gi = lb_ >> 4, q_ = (lb_ & 15) >> 2, p_ = lb_ & 3;
        const int g = wid >> 1, ch0 = g * 128 + (wid & 1) * 64;
        f32x16 acc[2][4];
#pragma unroll
        for (int ct = 0; ct < 2; ++ct)
#pragma unroll
            for (int tt = 0; tt < 4; ++tt) acc[ct][tt] = (f32x16){};
        const LAS unsigned char* abase = lds + (hi * 16 + (ch0 >> 5)) * 512 + q_ * 64 + (gi & 1) * 32 + p_ * 8;
        const bf16* wb = wsg + ((size_t)(g * 4 * 8) * 64 + lb_) * 8;
#pragma unroll
        for (int ks = 0; ks < 8; ++ks) {
            bf16x8 A[2];
#pragma unroll
            for (int ct = 0; ct < 2; ++ct) { const s16x4 lo = att::vtr(abase + (2 * ks * 16 + ct) * 512), hh = att::vtr(abase + (2 * ks * 16 + ct) * 512 + 256);
                A[ct] = (bf16x8){lo[0], lo[1], lo[2], lo[3], hh[0], hh[1], hh[2], hh[3]}; }
#pragma unroll
            for (int tt = 0; tt < 4; ++tt) if (ks < 2 * (tt + 1)) {
                const bf16x8 B = *(const GAS bf16x8*)(wb + (size_t)((tt * 8 + ks) * 64) * 8);
#pragma unroll
                for (int ct = 0; ct < 2; ++ct) acc[ct][tt] = __builtin_amdgcn_mfma_f32_32x32x16_bf16(A[ct], B, acc[ct][tt], 0, 0, 0); }
        }
        const float* bias = F.in[6] + g * 128;
        __syncthreads();
#pragma unroll
        for (int tt = 0; tt < 4; ++tt) { const int t = 32 * tt + r32; const float bs = bias[t];
#pragma unroll
            for (int ct = 0; ct < 2; ++ct)
#pragma unroll
                for (int rg = 0; rg < 4; ++rg) { const int c = ch0 + 32 * ct + 8 * rg + 4 * hi;
                    u32x2 w; w.x = cvtpk_s(acc[ct][tt][4 * rg] + bs, acc[ct][tt][4 * rg + 1] + bs); w.y = cvtpk_s(acc[ct][tt][4 * rg + 2] + bs, acc[ct][tt][4 * rg + 3] + bs);
                    *(LAS u32x2*)(lds + t * 1024 + ((((c >> 3) ^ (t & 15)) << 4) | ((c & 4) << 1))) = w; } }
    }
    int lc_ = lane; asm volatile("" : "+v"(lc_)); const int tidc = wid * 64 + lc_;
#pragma unroll
    for (int q = 8; q < 16; ++q) { const int idx = q * 512 + tidc, t = idx >> 6, chunk = idx & 63; uu[q] = __builtin_nontemporal_load((const GAS v4u*)(UV + pg8::kt_off(row0 + t, chunk * 8, 16))); }
    SG_MLOAD(0, tidc)
    __syncthreads();
    int ld_ = lane; asm volatile("" : "+v"(ld_)); const int tidd = wid * 64 + ld_;
#pragma unroll
    for (int q = 0; q < 16; ++q) { const int idx = q * 512 + tidd, t = idx >> 6, chunk = idx & 63;
        const v4u m = *(const LAS v4u*)(lds + t * 1024 + ((chunk ^ (t & 15)) << 4)); v4u o;
        o.x = cvtpk_s(bf_lo(uu[q].x) * bf_lo(m.x), bf_hi(uu[q].x) * bf_hi(m.x)); o.y = cvtpk_s(bf_lo(uu[q].y) * bf_lo(m.y), bf_hi(uu[q].y) * bf_hi(m.y));
        o.z = cvtpk_s(bf_lo(uu[q].z) * bf_lo(m.z), bf_hi(uu[q].z) * bf_hi(m.z)); o.w = cvtpk_s(bf_lo(uu[q].w) * bf_lo(m.w), bf_hi(uu[q].w) * bf_hi(m.w));
        *(GAS v4u*)(AB + pg8::img_off(row0 + t, chunk * 8, 16)) = o; }
    int le_ = lane; asm volatile("" : "+v"(le_)); const int tide = wid * 64 + le_;
    SG_MERGE(0, tide)
    SG_MLOAD(1, tide)
    int lf_ = lane; asm volatile("" : "+v"(lf_)); const int tidf = wid * 64 + lf_;
    SG_MERGE(1, tidf)
#undef SG_MLOAD
#undef SG_MERGE
    __syncthreads();
}

typedef float f32x2 __attribute__((ext_vector_type(2)));
__device__ __forceinline__ f32x2 bf_pair(unsigned w) { return (f32x2){bf_lo(w), bf_hi(w)}; }
__device__ __forceinline__ void conv_pair(Frame& F, int pair) {
    LAS unsigned char* lds = F.lds; int lane = mk_lane_id(); asm volatile("" : "+v"(lane)); const int wid = F.wave, tid = wid * 64 + lane;
    const int b = pair >> 5, tA = (pair & 31) * 128;
    const bf16* P1 = (const bf16*)(F.ws + WS_P1); bf16* CD = (bf16*)(F.ws + WS_CD);
    {
        v4u v[12];
#pragma unroll
        for (int i = 0; i < 12; ++i) { const int idx = i * 512 + tid, r = idx >> 6, pc = idx & 63, t = tA - 30 + r; v[i] = (v4u){0u, 0u, 0u, 0u};
            if (idx < 94 * 64 && t >= 0) v[i] = *(const GAS v4u*)(P1 + pg8::kt_off(b * SEQ + t, pc * 8, 24)); }
        f32x4 wv[8];
#pragma unroll
        for (int i = 0; i < 8; ++i) { const int idx = i * 512 + tid; wv[i] = (f32x4){0.f, 0.f, 0.f, 0.f}; if (idx < 31 * 128) wv[i] = *(const GAS f32x4*)(F.in[12] + (size_t)idx * 4); }
#pragma unroll
        for (int i = 0; i < 12; ++i) { const int idx = i * 512 + tid, r = idx >> 6, pc = idx & 63; if (idx < 94 * 64) *(LAS v4u*)(lds + r * 1024 + pc * 16) = v[i]; }
#pragma unroll
        for (int i = 0; i < 8; ++i) { const int idx = i * 512 + tid; if (idx < 31 * 128) { u32x2 w; w.x = cvtpk_s(wv[i][0], wv[i][1]); w.y = cvtpk_s(wv[i][2], wv[i][3]); *(LAS u32x2*)(lds + 94 * 1024 + idx * 8) = w; } }
    }
    __syncthreads();
    const LAS unsigned char* wrow = lds + 94 * 1024 + lane * 16;
#pragma nounroll
    for (int half = 0; half < 2; ++half) {
        int ln = lane; asm volatile("" : "+v"(ln)); const int c0 = 8 * ln;
        const int t0 = tA + 64 * half, row0 = b * SEQ + t0, tw = t0 + 8 * wid;
        const int rwrap = half ? 30 - 8 * wid : 0;
        const LAS unsigned char* xlo = lds + (8 * wid + 64) * 1024 + ln * 16;
        const LAS unsigned char* xhi = lds + (8 * wid - (half ? 30 : 0)) * 1024 + ln * 16;
        v4u gx[10], gg[8];
#pragma unroll
        for (int i = 0; i < 10; ++i) { const int t = tw - 2 + i; gx[i] = (v4u){0u, 0u, 0u, 0u}; if (t >= 0) gx[i] = *(const GAS v4u*)(P1 + pg8::kt_off(b * SEQ + t, 1024 + c0, 24)); }
        f32x2 acc[8][4];
        { const f32x4 ba = *(const GAS f32x4*)(F.in[13] + c0), bb = *(const GAS f32x4*)(F.in[13] + c0 + 4);
#pragma unroll
          for (int o = 0; o < 8; ++o) { acc[o][0] = (f32x2){ba[0], ba[1]}; acc[o][1] = (f32x2){ba[2], ba[3]}; acc[o][2] = (f32x2){bb[0], bb[1]}; acc[o][3] = (f32x2){bb[2], bb[3]}; } }
        asm volatile("" ::: "memory");
        f32x2 wt[8][4];
#define XADDR(r) (((r) < rwrap ? xlo : xhi) + (r) * 1024)
        v4u xq = *(const LAS v4u*)XADDR(0), wq = *(const LAS v4u*)(wrow);
#define CONV_ROW(r) { \
        const v4u xr = xq, wp = wq; \
        if ((r) + 1 < 38) xq = *(const LAS v4u*)XADDR((r) + 1); \
        if ((r) + 1 <= 30) wq = *(const LAS v4u*)(wrow + ((r) + 1) * 1024); \
        if ((r) <= 30) { wt[(r) & 7][0] = bf_pair(wp.x); wt[(r) & 7][1] = bf_pair(wp.y); wt[(r) & 7][2] = bf_pair(wp.z); wt[(r) & 7][3] = bf_pair(wp.w); } \
        const f32x2 x0 = bf_pair(xr.x), x1 = bf_pair(xr.y), x2 = bf_pair(xr.z), x3 = bf_pair(xr.w); \
        _Pragma("unroll") for (int o = 0; o < 8; ++o) { const int j = (r) - o; if (j >= 0 && j <= 30) { \
            acc[o][0] = __builtin_elementwise_fma(wt[j & 7][0], x0, acc[o][0]); acc[o][1] = __builtin_elementwise_fma(wt[j & 7][1], x1, acc[o][1]); \
            acc[o][2] = __builtin_elementwise_fma(wt[j & 7][2], x2, acc[o][2]); acc[o][3] = __builtin_elementwise_fma(wt[j & 7][3], x3, acc[o][3]); \
            asm volatile("" : "+v"(acc[o][0]), "+v"(acc[o][1]), "+v"(acc[o][2]), "+v"(acc[o][3])); } } \
        asm volatile("" ::: "memory"); }
        CONV_ROW(0) CONV_ROW(1) CONV_ROW(2) CONV_ROW(3) CONV_ROW(4) CONV_ROW(5) CONV_ROW(6) CONV_ROW(7)
        CONV_ROW(8) CONV_ROW(9) CONV_ROW(10) CONV_ROW(11) CONV_ROW(12) CONV_ROW(13) CONV_ROW(14) CONV_ROW(15)
        CONV_ROW(16) CONV_ROW(17) CONV_ROW(18) CONV_ROW(19) CONV_ROW(20) CONV_ROW(21) CONV_ROW(22) CONV_ROW(23)
        CONV_ROW(24) CONV_ROW(25) CONV_ROW(26) CONV_ROW(27) CONV_ROW(28) CONV_ROW(29) CONV_ROW(30) CONV_ROW(31)
        CONV_ROW(32) CONV_ROW(33) CONV_ROW(34) CONV_ROW(35) CONV_ROW(36) CONV_ROW(37)
#undef CONV_ROW
#undef XADDR
        asm volatile("" ::: "memory");
        int l2 = ln; asm volatile("" : "+v"(l2)); const int c1 = 8 * l2, tid2 = wid * 64 + l2;
#pragma unroll
        for (int o = 0; o < 8; ++o) gg[o] = *(const GAS v4u*)(P1 + pg8::kt_off(b * SEQ + tw + o, 512 + c1, 24));
        v4u nb[8];
        if (half == 0) {
#pragma unroll
            for (int i = 0; i < 8; ++i) { const int idx = i * 512 + tid2, r = idx >> 6, pc = idx & 63; nb[i] = *(const GAS v4u*)(P1 + pg8::kt_off(b * SEQ + tA + 64 + r, pc * 8, 24)); }
        }
        float st[16];
#pragma unroll
        for (int o = 0; o < 8; ++o) { float s1 = 0.f, s2 = 0.f;
#pragma unroll
            for (int c = 0; c < 4; ++c) { s1 += acc[o][c][0] + acc[o][c][1]; s2 += acc[o][c][0] * acc[o][c][0] + acc[o][c][1] * acc[o][c][1]; }
            st[o] = s1; st[8 + o] = s2; }
        reduce16(st, l2);
        LAS float* sw = (LAS float*)(lds + AUX_OFF) + wid * 16;
        if ((l2 & 3) == 0) sw[red16_idx(l2)] = st[0];
        asm volatile("" ::: "memory");
        const f32x4 ga = *(const GAS f32x4*)(F.in[14] + c1), gb = *(const GAS f32x4*)(F.in[14] + c1 + 4), la = *(const GAS f32x4*)(F.in[15] + c1), lb = *(const GAS f32x4*)(F.in[15] + c1 + 4);
        const float lg[8] = {ga[0], ga[1], ga[2], ga[3], gb[0], gb[1], gb[2], gb[3]}, lbv[8] = {la[0], la[1], la[2], la[3], lb[0], lb[1], lb[2], lb[3]};
#pragma unroll
        for (int o = 0; o < 8; ++o) { const float mean = sw[o] * (1.0f / 512.0f), var = fmaxf(sw[8 + o] * (1.0f / 512.0f) - mean * mean, 0.f), rstd = __builtin_amdgcn_rsqf(var + 1e-6f);
            float y[8];
#pragma unroll
            for (int c = 0; c < 8; ++c) { const float z = (acc[o][c >> 1][c & 1] - mean) * rstd * lg[c] + lbv[c]; y[c] = z * pg8::sigmoid_f(z); }
            v4u ov; ov.x = cvtpk_s(y[0], y[1]); ov.y = cvtpk_s(y[2], y[3]); ov.z = cvtpk_s(y[4], y[5]); ov.w = cvtpk_s(y[6], y[7]);
            *(GAS v4u*)(CD + pg8::img_off(row0 + 8 * wid + o, c1, 16)) = ov; }
        asm volatile("" ::: "memory");
        { const GAS float* dw = (const GAS float*)F.in[16] + c1;
          const f32x4 d0a = *(const GAS f32x4*)(dw), d0b = *(const GAS f32x4*)(dw + 4), d1a = *(const GAS f32x4*)(dw + 512), d1b = *(const GAS f32x4*)(dw + 516), d2a = *(const GAS f32x4*)(dw + 1024), d2b = *(const GAS f32x4*)(dw + 1028);
          const float w0[8] = {d0a[0], d0a[1], d0a[2], d0a[3], d0b[0], d0b[1], d0b[2], d0b[3]}, w1[8] = {d1a[0], d1a[1], d1a[2], d1a[3], d1b[0], d1b[1], d1b[2], d1b[3]}, w2[8] = {d2a[0], d2a[1], d2a[2], d2a[3], d2b[0], d2b[1], d2b[2], d2b[3]};
#pragma unroll
          for (int o = 0; o < 8; ++o) { const v4u xa = gx[o], xb = gx[o + 1], xc = gx[o + 2], gv = gg[o];
              const float A[8] = {bf_lo(xa.x), bf_hi(xa.x), bf_lo(xa.y), bf_hi(xa.y), bf_lo(xa.z), bf_hi(xa.z), bf_lo(xa.w), bf_hi(xa.w)}, B[8] = {bf_lo(xb.x), bf_hi(xb.x), bf_lo(xb.y), bf_hi(xb.y), bf_lo(xb.z), bf_hi(xb.z), bf_lo(xb.w), bf_hi(xb.w)};
              const float C[8] = {bf_lo(xc.x), bf_hi(xc.x), bf_lo(xc.y), bf_hi(xc.y), bf_lo(xc.z), bf_hi(xc.z), bf_lo(xc.w), bf_hi(xc.w)}, Gv[8] = {bf_lo(gv.x), bf_hi(gv.x), bf_lo(gv.y), bf_hi(gv.y), bf_lo(gv.z), bf_hi(gv.z), bf_lo(gv.w), bf_hi(gv.w)};
              float d[8];
#pragma unroll
              for (int c = 0; c < 8; ++c) d[c] = Gv[c] * (w0[c] * A[c] + w1[c] * B[c] + w2[c] * C[c]);
              v4u ov; ov.x = cvtpk_s(d[0], d[1]); ov.y = cvtpk_s(d[2], d[3]); ov.z = cvtpk_s(d[4], d[5]); ov.w = cvtpk_s(d[6], d[7]);
              *(GAS v4u*)(CD + pg8::img_off(row0 + 8 * wid + o, 512 + c1, 16)) = ov; } }
        __syncthreads();
        if (half == 0) {
#pragma unroll
            for (int i = 0; i < 8; ++i) { const int idx = i * 512 + tid2, r = idx >> 6, pc = idx & 63; *(LAS v4u*)(lds + r * 1024 + pc * 16) = nb[i]; }
            __syncthreads();
        }
    }
}

#ifndef MK_REP_SG
#define MK_REP_SG 1
#endif
#ifndef MK_REP_CONV
#define MK_REP_CONV 1
#endif
constexpr int NPHASES = 12;
struct Args { const float* in[22]; float* out; unsigned char* ws; int ph_lo, ph_hi; };
__global__ void __launch_bounds__(NWAVES * 64, 2) mk_fwd(Args args) {
    extern __shared__ __attribute__((aligned(16))) unsigned char lds_raw[];
    Frame F;
    F.lds = (LAS unsigned char*)lds_raw;
    F.MISC = (volatile LAS unsigned*)(F.lds + MISC_OFF);
    F.wave = __builtin_amdgcn_readfirstlane((int)threadIdx.x >> 6);
    F.G = gridDim.x; { const int bx = blockIdx.x; F.vcu = (F.G % 8 == 0) ? (bx % 8) * (F.G / 8) + bx / 8 : bx; }
    unsigned char* ws = args.ws; F.ws = ws; F.out = args.out;
#pragma unroll
    for (int i = 0; i < 22; ++i) F.in[i] = args.in[i];
    F.ctl = (gu32*)(ws + WS_CTL);
    for (int u = threadIdx.x; u < 1024 / 4; u += NWAVES * 64) ((LAS unsigned*)(F.lds + LDSCTL_OFF))[u] = 0u;
    __syncthreads();
    const int lo = args.ph_lo, hi = args.ph_hi;
    XcdBarrier bar; bar.bar = (unsigned*)(F.ctl + CW_BAR); bar.x = 0; bar.st = nullptr;
    if (hi - lo > 1) bar = xcd_barrier_post((unsigned*)(F.ctl + CW_BAR), F.MISC + 8);
#define IN(k) (lo <= (k) && (k) < hi)
#define SEAM(k) do { if (IN(k) && IN((k) + 1)) xcd_barrier(bar); } while (0)
    float* rss = (float*)(ws + WS_RSS);
    bf16* XB = (bf16*)(ws + WS_XB);
    LAS unsigned char* xs = F.lds + XP_OFF + F.wave * 2304;

    if (IN(0)) { p0_prologue(F); SEAM(0); }
    if (IN(1)) {
        pg8::Gemm g{XB, (const bf16*)(ws + WS_W0IN), T, AB_IN, DM}; pg8::StaticOrder S; S.init(T, AB_IN, F.G, (int)blockIdx.x);
        pg8::EpiIn0 E{rss, (bf16*)(ws + WS_UV), (bf16*)(ws + WS_Q), (bf16*)(ws + WS_K), (bf16*)(ws + WS_V), F.in[7], F.in[8], (const float*)(ws + WS_ROPE), xs};
        pg8::gemm_phase<pg8::EpiIn0, pg8::StaticOrder, true, true>(F.lds + RING_OFF, g, S, E, F.wave);
        SEAM(1);
    }
    if (IN(2)) {
        att::attn_phase(F.lds, F.vcu, F.G, (const bf16*)(ws + WS_Q), (const bf16*)(ws + WS_K), (const bf16*)(ws + WS_V), (bf16*)(ws + WS_Q), (float*)(ws + WS_LSE), F.wave);
        SEAM(2);
    }
    if (IN(3)) {
        for (int rep = 0; rep < MK_REP_SG; ++rep) for (int u = F.vcu; u < T / 128; u += F.G) sg_unit(F, u);
        SEAM(3);
    }
    if (IN(4)) {
        pg8::Gemm g{(const bf16*)(ws + WS_AB), (const bf16*)(ws + WS_W0OUT), T, DM, DM}; pg8::StaticOrder S; S.init(T, DM, F.G, (int)blockIdx.x);
        pg8::EpiRes E{XB, nullptr, rss + T, xs};
        pg8::gemm_phase<pg8::EpiRes, pg8::StaticOrder, true, true>(F.lds + RING_OFF, g, S, E, F.wave);
        SEAM(4);
    }
    if (IN(5)) {
        pg8::Gemm g{XB, (const bf16*)(ws + WS_W0GU), T, GU_N, DM}; pg8::StaticOrder S; S.init(T, GU_N, F.G, (int)blockIdx.x);
        pg8::EpiGUT<true> E{rss + T, (bf16*)(ws + WS_ACT), DFF, xs, (const pg8::DwTab*)(ws + WS_DWTAB)};
        pg8::gemm_phase<pg8::EpiGUT<true>, pg8::StaticOrder, true, true>(F.lds + RING_OFF, g, S, E, F.wave);
        SEAM(5);
    }
    if (IN(6)) {
        pg8::Gemm g{(const bf16*)(ws + WS_ACT), (const bf16*)(ws + WS_W0D), T, DM, DFF}; pg8::StaticOrder S; S.init(T, DM, F.G, (int)blockIdx.x);
        pg8::EpiRes E{XB, nullptr, rss + 2 * T, xs};
        pg8::gemm_phase<pg8::EpiRes, pg8::StaticOrder, true, true>(F.lds + RING_OFF, g, S, E, F.wave);
        SEAM(6);
    }
    if (IN(7)) {
        pg8::Gemm g{XB, (const bf16*)(ws + WS_W1IN), T, CD_IN, DM}; pg8::StaticOrder S; S.init(T, CD_IN, F.G, (int)blockIdx.x);
        pg8::EpiIn1 E{rss + 2 * T, (bf16*)(ws + WS_P1), xs};
        pg8::gemm_phase<pg8::EpiIn1, pg8::StaticOrder, true, true>(F.lds + RING_OFF, g, S, E, F.wave);
        SEAM(7);
    }
    if (IN(8)) {
        for (int rep = 0; rep < MK_REP_CONV; ++rep) for (int u = F.vcu; u < T / 128; u += F.G) conv_pair(F, u);
        SEAM(8);
    }
    if (IN(9)) {
        pg8::Gemm g{(const bf16*)(ws + WS_CD), (const bf16*)(ws + WS_W1OUT), T, DM, DM}; pg8::StaticOrder S; S.init(T, DM, F.G, (int)blockIdx.x);
        pg8::EpiRes E{XB, nullptr, rss + 3 * T, xs};
        pg8::gemm_phase<pg8::EpiRes, pg8::StaticOrder, true, true>(F.lds + RING_OFF, g, S, E, F.wave);
        SEAM(9);
    }
    if (IN(10)) {
        pg8::Gemm g{XB, (const bf16*)(ws + WS_W1GU), T, GU_N, DM}; pg8::StaticOrder S; S.init(T, GU_N, F.G, (int)blockIdx.x);
        pg8::EpiGUT<false> E{rss + 3 * T, (bf16*)(ws + WS_ACT), DFF, xs, nullptr};
        pg8::gemm_phase<pg8::EpiGUT<false>, pg8::StaticOrder, true, true>(F.lds + RING_OFF, g, S, E, F.wave);
        SEAM(10);
    }
    if (IN(11)) {
        pg8::Gemm g{(const bf16*)(ws + WS_ACT), (const bf16*)(ws + WS_W1D), T, DM, DFF}; pg8::StaticOrder S; S.init(T, DM, F.G, (int)blockIdx.x);
        pg8::EpiRes E{XB, F.out, nullptr, xs};
        pg8::gemm_phase<pg8::EpiRes, pg8::StaticOrder, true, true>(F.lds + RING_OFF, g, S, E, F.wave);
    }
#undef IN
#undef SEAM
}

#ifndef MK_PER_PHASE
#define MK_PER_PHASE 0
#endif
extern "C" void kernel_launch(void* const* d_in, const int* in_sizes, int n_in, void* d_out, int out_size, void* d_ws, size_t ws_size, hipStream_t stream) {
    static int grid = 0;
    if (grid == 0) {
        if (n_in != 22 || in_sizes[0] != T * DM || out_size != T * DM || ws_size < WS_END) { fprintf(stderr, "kernel_launch: unexpected shapes: n_in %d in0 %d out %d ws %zu (need %zu); nothing launched\n", n_in, n_in > 0 ? in_sizes[0] : -1, out_size, ws_size, (size_t)WS_END); grid = -1; return; }
        int dev = 0, cus = 0, per_cu = 0;
        if (hipGetDevice(&dev) != hipSuccess || hipDeviceGetAttribute(&cus, hipDeviceAttributeMultiprocessorCount, dev) != hipSuccess) { fprintf(stderr, "kernel_launch: device query failed\n"); grid = -1; return; }
        if (hipFuncSetAttribute((const void*)mk_fwd, hipFuncAttributeMaxDynamicSharedMemorySize, LDS_BYTES) != hipSuccess) { fprintf(stderr, "kernel_launch: hipFuncSetAttribute failed\n"); grid = -1; return; }
        if (hipOccupancyMaxActiveBlocksPerMultiprocessor(&per_cu, (const void*)mk_fwd, NWAVES * 64, LDS_BYTES) != hipSuccess || per_cu < 1) { fprintf(stderr, "kernel_launch: occupancy query says %d blocks per CU\n", per_cu); per_cu = 1; }
        (void)hipGetLastError();
        grid = cus;
        if (grid % 8 != 0 || grid > 256) grid = (grid / 8) * 8 > 256 ? 256 : (grid / 8) * 8;
    }
    if (grid <= 0) return;
    (void)hipMemsetAsync((char*)d_ws + WS_CTL, 0, CTL_ZERO_BYTES, stream);
    Args a{};
    for (int i = 0; i < 22; ++i) a.in[i] = (const float*)d_in[i];
    a.out = (float*)d_out; a.ws = (unsigned char*)d_ws;
#if MK_PER_PHASE
    for (int p = 0; p < NPHASES; ++p) { a.ph_lo = p; a.ph_hi = p + 1; hipLaunchKernelGGL(mk_fwd, dim3(grid), dim3(NWAVES * 64), LDS_BYTES, stream, a); }
#else
    a.ph_lo = 0; a.ph_hi = NPHASES;
    hipLaunchKernelGGL(mk_fwd, dim3(grid), dim3(NWAVES * 64), LDS_BYTES, stream, a);
#endif
    const hipError_t le = hipPeekAtLastError();
    if (le != hipSuccess) fprintf(stderr, "kernel_launch: launch failed: %s\n", hipGetErrorName(le));
}
```
